# Optimizing an MI355X kernel written in HIP

```python
import jax, jax.numpy as jnp
from jax import lax
import numpy as np

D_MODEL = 1024
BATCH = 32
SEQ = 256
DEPTH = 2
DEC_BATCH = 4
DEC_SEQ = 1024
PAST_LEN = 256

GRID_W = 64
D_A = 512
LRU_BLOCKS = 8
LRU_BW = D_A // LRU_BLOCKS
CONV_W = 4
CONV_LEFT = 1
LRU_C = 8.0
D_B = 512
HG_HEADS = 4
HG_DK = D_B // HG_HEADS
HG_DV = D_B // HG_HEADS
HG_CHUNK = 32
F_MIN = 1e-20
D_C = 512
RET_HEADS = 4
RET_DK = D_C // RET_HEADS
RET_DV = D_C // RET_HEADS
RET_CHUNK = 64
ROPE_BASE = 10000.0
D_MIX = D_A + D_B + D_C
IN_WIDTHS = (D_A, D_A, D_B, D_B, D_B, D_B, D_B, D_C, D_C, D_C, D_C)
D_IN = 2 * D_A + 5 * D_B + 4 * D_C
EPS = 1e-6

kernel_name = "hybrid_lru_hgrn2_retention_diffusion_step"

F32 = jnp.float32


def _rmsnorm(x, g):
    xf = x.astype(F32)
    y = xf * lax.rsqrt(jnp.mean(xf * xf, axis=-1, keepdims=True) + EPS)
    return (y * g.astype(F32)).astype(x.dtype)


def _head_rmsnorm(y, g, n_heads):
    bn, ln, w = y.shape
    yh = y.reshape(bn, ln, n_heads, w // n_heads)
    yh = yh * lax.rsqrt(jnp.mean(yh * yh, axis=-1, keepdims=True) + EPS)
    return (yh * g.astype(F32).reshape(n_heads, -1)).reshape(bn, ln, w)


def _comb(e1, e2):
    a1, b1 = e1
    a2, b2 = e2
    return a1 * a2, a2 * b1 + b2


def _lin_scan(a, b, h0, reverse):
    if reverse:
        a = jnp.flip(a, 1)
        b = jnp.flip(b, 1)
    a_cum, b_cum = lax.associative_scan(_comb, (a, b), axis=1)
    h = a_cum * h0[:, None, :] + b_cum
    h_fin = h[:, -1]
    if reverse:
        h = jnp.flip(h, 1)
    return h, h_fin


def _rg_lru(xa, conv_w, conv_b, wa, ba, wx, bx, lam, h0):
    bn, ln, _ = xa.shape
    xp = jnp.pad(xa, ((0, 0), (CONV_LEFT, CONV_W - 1 - CONV_LEFT), (0, 0)))
    u = conv_b
    for k in range(CONV_W):
        u = u + xp[:, k:k + ln] * conv_w[k]
    uf = u.astype(F32)
    ub = uf.reshape(bn, ln, LRU_BLOCKS, LRU_BW)
    y = jnp.zeros_like(uf)
    fins = []
    for d in range(2):
        r = jax.nn.sigmoid(jnp.einsum('blhi,hij->blhj', ub, wa[d].astype(F32)).reshape(bn, ln, D_A) + ba[d].astype(F32))
        ig = jax.nn.sigmoid(jnp.einsum('blhi,hij->blhj', ub, wx[d].astype(F32)).reshape(bn, ln, D_A) + bx[d].astype(F32))
        log_a = -LRU_C * r * jax.nn.softplus(-lam[d].astype(F32))
        a = jnp.exp(log_a)
        b = jnp.sqrt(-jnp.expm1(2.0 * log_a)) * (ig * uf)
        h, h_fin = _lin_scan(a, b, h0[:, d].astype(F32), reverse=(d == 1))
        y = y + h
        fins.append(h_fin)
    return y, jnp.stack(fins, axis=1)


def _hgrn2_dir(q, k, v, logf, s0):
    bn, ln, nh, dk = q.shape
    dv = v.shape[-1]
    n = ln // HG_CHUNK

    def to_chunks(t):
        return t.reshape(bn, n, HG_CHUNK, nh, t.shape[-1]).transpose(1, 0, 3, 2, 4)

    mask = jnp.tril(jnp.ones((HG_CHUNK, HG_CHUNK), dtype=bool))[:, :, None]

    def step(s, inp):
        qc, kc, vc, lf = inp
        b = jnp.cumsum(lf, axis=2)
        inter = jnp.einsum('bhtd,bhde->bhte', qc * jnp.exp(b), s)
        diff = b[:, :, :, None, :] - b[:, :, None, :, :]
        dec = jnp.where(mask, jnp.exp(jnp.where(mask, diff, 0.0)), 0.0)
        att = jnp.einsum('bhtd,bhtsd,bhsd->bhts', qc, dec, kc)
        intra = jnp.einsum('bhts,bhse->bhte', att, vc)
        bl = b[:, :, -1:, :]
        s_new = jnp.exp(bl[:, :, 0, :])[..., None] * s + jnp.einsum('bhsd,bhse->bhde', kc * jnp.exp(bl - b), vc)
        return s_new, inter + intra

    s_fin, o = lax.scan(step, s0, (to_chunks(q), to_chunks(k), to_chunks(v), to_chunks(logf)))
    o = o.transpose(1, 0, 3, 2, 4).reshape(bn, ln, nh, dv)
    return o, s_fin


def _hgrn2(hq, hf_f, hf_b, hi, lb, s0):
    bn, ln, _ = hq.shape
    q = jax.nn.silu(hq.astype(F32)).reshape(bn, ln, HG_HEADS, HG_DK)
    v = hi.astype(F32).reshape(bn, ln, HG_HEADS, HG_DV)
    y = jnp.zeros((bn, ln, HG_HEADS, HG_DV), F32)
    fins = []
    for d, z in enumerate((hf_f, hf_b)):
        zf = z.astype(F32)
        lbd = lb[d]
        f = lbd + (1.0 - lbd) * jax.nn.sigmoid(zf)
        logf = jnp.log(jnp.maximum(f, F_MIN))
        k = (1.0 - lbd) * jax.nn.sigmoid(-zf)
        logf = logf.reshape(bn, ln, HG_HEADS, HG_DK)
        k = k.reshape(bn, ln, HG_HEADS, HG_DK)
        qd, vd = q, v
        if d == 1:
            qd, k, vd, logf = (jnp.flip(t, 1) for t in (qd, k, vd, logf))
        o, s_fin = _hgrn2_dir(qd, k, vd, logf, s0[:, d].astype(F32))
        if d == 1:
            o = jnp.flip(o, 1)
        y = y + o
        fins.append(s_fin)
    return y.reshape(bn, ln, D_B), jnp.stack(fins, axis=1)


def _rope_grid(x):
    ln = x.shape[1]
    rows = ln // GRID_W
    pos_r = jnp.broadcast_to(jnp.arange(rows, dtype=F32)[:, None], (rows, GRID_W)).reshape(-1)
    pos_c = jnp.broadcast_to(jnp.arange(GRID_W, dtype=F32)[None, :], (rows, GRID_W)).reshape(-1)
    half = x.shape[-1] // 2
    nf = half // 2
    freq = ROPE_BASE ** (-jnp.arange(nf, dtype=F32) / nf)

    def rot(t, pos):
        ang = pos[:, None] * freq[None, :]
        cos = jnp.cos(ang)[None, :, None, :]
        sin = jnp.sin(ang)[None, :, None, :]
        a, b = t[..., :nf], t[..., nf:]
        return jnp.concatenate([a * cos - b * sin, a * sin + b * cos], axis=-1)

    return jnp.concatenate([rot(x[..., :half], pos_r), rot(x[..., half:], pos_c)], axis=-1)


def _ret_dir(q, k, v, lg, s0):
    bn, ln, nh, dk = q.shape
    dv = v.shape[-1]
    c = RET_CHUNK
    n = ln // c
    qc = q.reshape(bn, n, c, nh, dk)
    kc = k.reshape(bn, n, c, nh, dk)
    vc = v.reshape(bn, n, c, nh, dv)
    j = jnp.arange(c, dtype=F32)
    rel = j[:, None] - j[None, :]
    mask = rel >= 0
    dmat = jnp.where(mask[None], jnp.exp(jnp.where(mask, rel, 0.0)[None] * lg[:, None, None]), 0.0)
    sc = jnp.einsum('bnthd,bnshd->bnhts', qc, kc) * dmat[None, None]
    intra = jnp.einsum('bnhts,bnshe->bnthe', sc, vc)
    kv = jnp.einsum('bnshd,hs,bnshe->bnhde', kc, jnp.exp((c - 1.0 - j)[None, :] * lg[:, None]), vc)
    g_c = jnp.exp(c * lg)[:, None, None]

    def step(s, kv_n):
        return g_c * s + kv_n, s

    s_fin, s_before = lax.scan(step, s0, jnp.moveaxis(kv, 1, 0))
    s_before = jnp.moveaxis(s_before, 0, 1)
    inter = jnp.einsum('bnthd,ht,bnhde->bnthe', qc, jnp.exp((j + 1.0)[None, :] * lg[:, None]), s_before)
    return (intra + inter).reshape(bn, ln, nh, dv), s_fin


def _retention(rq, rk, rv, decay_logit, s0, latent):
    bn, ln, _ = rq.shape
    q = rq.astype(F32).reshape(bn, ln, RET_HEADS, RET_DK)
    k = rk.astype(F32).reshape(bn, ln, RET_HEADS, RET_DK)
    v = rv.astype(F32).reshape(bn, ln, RET_HEADS, RET_DV)
    if latent:
        q = _rope_grid(q)
        k = _rope_grid(k)
    q = q * (RET_DK ** -0.5)
    lg_all = jax.nn.log_sigmoid(decay_logit.astype(F32))
    y = jnp.zeros((bn, ln, RET_HEADS, RET_DV), F32)
    fins = []
    for d in range(2):
        qd, kd, vd = q, k, v
        if d == 1:
            qd, kd, vd = (jnp.flip(t, 1) for t in (qd, kd, vd))
        o, s_fin = _ret_dir(qd, kd, vd, lg_all[d], s0[:, d].astype(F32))
        if d == 1:
            o = jnp.flip(o, 1)
        y = y + o
        fins.append(s_fin)
    return y.reshape(bn, ln, D_C), jnp.stack(fins, axis=1)


def _layer(x, cond, s_lru, s_hg, s_ret, p, l, latent):
    m = jax.nn.silu(cond) @ p['w_mod'][l] + p['b_mod'][l]
    shift, scale, gate = jnp.split(m[:, None, :], 3, axis=-1)
    xn = _rmsnorm(x, p['norm_g'][l]) * (1.0 + scale) + shift
    proj = xn @ p['w_in'][l]
    offs = []
    s = 0
    for w in IN_WIDTHS[:-1]:
        s += w
        offs.append(s)
    xa, ga, hq, hf_f, hf_b, hi, hg, rq, rk, rv, rg = jnp.split(proj, offs, axis=-1)
    ya, fin_lru = _rg_lru(xa, p['conv_w'][l], p['conv_b'][l], p['lru_wa'][l], p['lru_ba'][l],
                          p['lru_wx'][l], p['lru_bx'][l], p['lru_lambda'][l], s_lru)
    lbp = jax.nn.softmax(p['hgrn_lb_logits'].astype(F32), axis=0)
    lb = (jnp.cumsum(lbp, axis=0) - lbp[0])[l]
    yb, fin_hg = _hgrn2(hq, hf_f, hf_b, hi, lb, s_hg)
    yb = _head_rmsnorm(yb, p['hgrn_norm_g'][l], HG_HEADS)
    yc, fin_ret = _retention(rq, rk, rv, p['ret_decay_logit'][l], s_ret, latent)
    yc = _head_rmsnorm(yc, p['ret_norm_g'][l], RET_HEADS)
    ycat = jnp.concatenate([ya * jax.nn.silu(ga.astype(F32)), yb * jax.nn.silu(hg.astype(F32)),
                            yc * jax.nn.silu(rg.astype(F32))], axis=-1).astype(x.dtype)
    x = x + gate * (ycat @ p['w_out'][l])
    return x, fin_lru, fin_hg, fin_ret


def setup_inputs(seed: int = 0) -> dict:
    key = jax.random.key(seed)
    ks = jax.random.split(key, 24)
    nrm = jax.random.normal
    u = jax.random.uniform(ks[17], (DEPTH, 2, D_A), F32, 0.9, 0.999)
    a0 = u ** (1.0 / LRU_C)
    ret_base = jnp.log(2.0 ** (5.0 + jnp.arange(RET_HEADS, dtype=F32)) - 1.0)
    return {
        "x_prompt": nrm(ks[0], (BATCH, SEQ, D_MODEL), F32),
        "x_sample": nrm(ks[1], (DEC_BATCH, DEC_SEQ, D_MODEL), F32),
        "state_lru": nrm(ks[2], (DEC_BATCH, DEPTH, 2, D_A), F32),
        "state_hgrn": nrm(ks[3], (DEC_BATCH, DEPTH, 2, HG_HEADS, HG_DK, HG_DV), F32),
        "state_ret": nrm(ks[4], (DEC_BATCH, DEPTH, 2, RET_HEADS, RET_DK, RET_DV), F32),
        "c": nrm(ks[5], (DEC_BATCH, D_MODEL), F32),
        "c_ctx": nrm(ks[6], (D_MODEL,), F32),
        "norm_g": 1.0 + 0.02 * nrm(ks[7], (DEPTH, D_MODEL), F32),
        "w_mod": nrm(ks[8], (DEPTH, D_MODEL, 3 * D_MODEL), F32) * (0.5 * D_MODEL ** -0.5),
        "b_mod": 0.01 * nrm(ks[9], (DEPTH, 3 * D_MODEL), F32),
        "w_in": nrm(ks[10], (DEPTH, D_MODEL, D_IN), F32) * (D_MODEL ** -0.5),
        "conv_w": nrm(ks[11], (DEPTH, CONV_W, D_A), F32) * (CONV_W ** -0.5),
        "conv_b": 0.01 * nrm(ks[12], (DEPTH, D_A), F32),
        "lru_wa": nrm(ks[13], (DEPTH, 2, LRU_BLOCKS, LRU_BW, LRU_BW), F32) * (LRU_BW ** -0.5),
        "lru_ba": 0.01 * nrm(ks[14], (DEPTH, 2, D_A), F32),
        "lru_wx": nrm(ks[15], (DEPTH, 2, LRU_BLOCKS, LRU_BW, LRU_BW), F32) * (LRU_BW ** -0.5),
        "lru_bx": 0.01 * nrm(ks[16], (DEPTH, 2, D_A), F32),
        "lru_lambda": jnp.log(a0) - jnp.log1p(-a0),
        "hgrn_lb_logits": nrm(ks[18], (DEPTH, 2, D_B), F32),
        "hgrn_norm_g": 1.0 + 0.02 * nrm(ks[19], (DEPTH, D_B), F32),
        "ret_decay_logit": ret_base + 0.01 * nrm(ks[20], (DEPTH, 2, RET_HEADS), F32),
        "ret_norm_g": 1.0 + 0.02 * nrm(ks[21], (DEPTH, D_C), F32),
        "w_out": nrm(ks[22], (DEPTH, D_MIX, D_MODEL), F32) * (D_MIX ** -0.5),
        "final_g": 1.0 + 0.02 * nrm(ks[23], (D_MODEL,), F32),
    }


def reference(x_prompt, x_sample, state_lru, state_hgrn, state_ret, c, c_ctx, norm_g, w_mod, b_mod, w_in,
              conv_w, conv_b, lru_wa, lru_ba, lru_wx, lru_bx, lru_lambda, hgrn_lb_logits, hgrn_norm_g,
              ret_decay_logit, ret_norm_g, w_out, final_g):
    p = dict(norm_g=norm_g, w_mod=w_mod, b_mod=b_mod, w_in=w_in, conv_w=conv_w, conv_b=conv_b,
             lru_wa=lru_wa, lru_ba=lru_ba, lru_wx=lru_wx, lru_bx=lru_bx, lru_lambda=lru_lambda,
             hgrn_lb_logits=hgrn_lb_logits, hgrn_norm_g=hgrn_norm_g, ret_decay_logit=ret_decay_logit,
             ret_norm_g=ret_norm_g, w_out=w_out)
    bp = x_prompt.shape[0]
    z_lru = jnp.zeros((bp, 2, D_A), F32)
    z_hg = jnp.zeros((bp, 2, HG_HEADS, HG_DK, HG_DV), F32)
    z_ret = jnp.zeros((bp, 2, RET_HEADS, RET_DK, RET_DV), F32)
    x = x_prompt
    lru_l, hg_l, ret_l = [], [], []
    for l in range(DEPTH):
        x, f_lru, f_hg, f_ret = _layer(x, c_ctx[None, :], z_lru, z_hg, z_ret, p, l, latent=False)
        lru_l.append(f_lru)
        hg_l.append(f_hg)
        ret_l.append(f_ret)
    y_prompt = _rmsnorm(x, final_g)
    new_lru = jnp.stack(lru_l, axis=1)
    new_hgrn = jnp.stack(hg_l, axis=1)
    new_ret = jnp.stack(ret_l, axis=1)
    z = x_sample
    for l in range(DEPTH):
        z, _, _, _ = _layer(z, c, state_lru[:, l], state_hgrn[:, l], state_ret[:, l], p, l, latent=True)
    y_sample = _rmsnorm(z, final_g)
    return (y_prompt, y_sample, new_lru, new_hgrn, new_ret)
```

```cpp
#include <hip/hip_runtime.h>
#include <hip/hip_cooperative_groups.h>
#include <cstdio>
namespace pg8 {
#define PG8_LAS __attribute__((address_space(3)))
typedef unsigned short bf16_t;
typedef short bf16x8 __attribute__((ext_vector_type(8)));
typedef float f32x4 __attribute__((ext_vector_type(4)));
typedef unsigned u32x4 __attribute__((ext_vector_type(4)));
constexpr int BM = 256, BK = 64, HALF = 128, HTB = HALF * BK * 2  , STAGE_BYTES = 8 * HTB, NXCD = 8, WGM = 8;

__host__ __device__ __forceinline__ int lds_byte(int r, int c) { const int st = (r >> 4) * 2 + (c >> 5), rr = r & 15, cc = c & 31, ob = rr * 64 + cc * 2; return st * 1024 + (ob ^ (((ob >> 9) & 1) << 5)); }
__host__ __device__ __forceinline__ void stage_rc(int b, int& R, int& C) { const int st = b / 1024, sb = b % 1024, swz = sb ^ (((sb >> 9) & 1) << 5); R = (st >> 1) * 16 + swz / 64; C = (st & 1) * 32 + (swz % 64) / 2; }
__host__ __device__ __forceinline__ int perm32(int rho) { const int n = rho >> 4, i = rho & 15; return 8 * (i >> 2) + 4 * n + (i & 3); }

struct Unit { int pm, pn; };
struct Gemm { const bf16_t* A; const bf16_t* Bt; int M, N, K; };

struct StaticOrder {
    int nM, nN, nwg, G, c;
    __host__ __device__ void init(int M, int N, int G_, int c_) { nM = M / BM; nN = N / BM; nwg = nM * nN; G = G_; c = c_; }
    __host__ __device__ bool next(int i, Unit& u) const {
        const long L = (long)i * G + c; if (L >= nwg) return false;
        int wgid = (int)L; { const int q = nwg / NXCD, r = nwg % NXCD, xcd = wgid % NXCD, off = wgid / NXCD; wgid = (xcd < r ? xcd * (q + 1) : r * (q + 1) + (xcd - r) * q) + off; }
        const int nig = WGM * nN, gid = wgid / nig, fm = gid * WGM, gsz = (nM - fm) < WGM ? (nM - fm) : WGM;
        u.pm = fm + ((wgid % nig) % gsz); u.pn = (wgid % nig) / gsz; return true;
    }
    __device__ __forceinline__ void a_ready(const Unit&) const {}
    __device__ __forceinline__ void done(const Unit&) const {}
};
struct CountedOrder : StaticOrder {
    const unsigned* ready; unsigned need; unsigned* tmo;
    __device__ __forceinline__ void a_ready(const Unit& u) const {
        if (threadIdx.x < 64) {
            const unsigned long long t0 = __builtin_amdgcn_s_memrealtime(); unsigned polls = 0;
            while ((unsigned)__builtin_amdgcn_readfirstlane(__hip_atomic_load(ready + 64 * u.pm, __ATOMIC_RELAXED, __HIP_MEMORY_SCOPE_AGENT)) < need) {
                if ((++polls & 255u) == 0u && __builtin_amdgcn_readfirstlane(__hip_atomic_load(tmo, __ATOMIC_RELAXED, __HIP_MEMORY_SCOPE_AGENT)) != 0u) break;
                if (__builtin_amdgcn_s_memrealtime() - t0 > 2000000ull) {
                    if (threadIdx.x == 0) { unsigned expect = 0u; __hip_atomic_compare_exchange_strong(tmo + 1, &expect, 0x600u | (unsigned)(u.pm & 0xff), __ATOMIC_RELAXED, __ATOMIC_RELAXED, __HIP_MEMORY_SCOPE_AGENT); __hip_atomic_store(tmo, 1u, __ATOMIC_RELAXED, __HIP_MEMORY_SCOPE_AGENT); }
                    break; }
                __builtin_amdgcn_s_sleep(2); }
            __builtin_amdgcn_fence(__ATOMIC_ACQUIRE, "agent");
            asm volatile("s_waitcnt vmcnt(0)" ::: "memory");
        }
#if !defined(BROKEN_HOOK_NO_BARRIER)
        asm volatile("" ::: "memory"); __builtin_amdgcn_s_barrier(); asm volatile("" ::: "memory");
#endif
    }
};

__device__ __forceinline__ unsigned cvt_pk_bf16(float lo, float hi) { unsigned r; asm volatile("v_cvt_pk_bf16_f32 %0, %1, %2" : "=v"(r) : "v"(lo), "v"(hi)); return r; }
typedef float f32x2 __attribute__((ext_vector_type(2)));
__device__ __forceinline__ f32x2 gelu_pk(f32x2 v) {
    const f32x2 av = __builtin_elementwise_abs(v), d = av * 0.2316418882f + 1.0f;
    f32x2 t; t.x = __builtin_amdgcn_rcpf(d.x); t.y = __builtin_amdgcn_rcpf(d.y);
    f32x2 q = t * 0.5307027145f + (-0.7265760135f); q = q * t + 0.7107068705f; q = q * t + (-0.142248368f); q = q * t + 0.127414796f; q = q * t;
    const f32x2 s = (v * v) * (-0.72134752044f);
    f32x2 e; e.x = __builtin_amdgcn_exp2f(s.x); e.y = __builtin_amdgcn_exp2f(s.y);
    const f32x2 m = v * (q * e), r = v - m;
    f32x2 o; o.x = v.x < 0.f ? m.x : r.x; o.y = v.y < 0.f ? m.y : r.y; return o;
}

struct EpiF32 {
    static constexpr bool PERM = false, AFTER_DRAIN = false;
    float* C; int ldc; const float* bias;
    __device__ __forceinline__ void operator()(const f32x4 (&acc)[2][2][4][2], const Unit& u, int wr, int wc, int fr, int fq) const {
        const int row0 = u.pm * BM + wr * 64 + fr, col0 = u.pn * BM + wc * 32 + 4 * fq;
        f32x4 bv[2][2];
#pragma unroll
        for (int bj = 0; bj < 2; ++bj)
#pragma unroll
            for (int n = 0; n < 2; ++n) bv[bj][n] = bias ? *(const f32x4*)(bias + col0 + bj * HALF + n * 16) : (f32x4){0.f, 0.f, 0.f, 0.f};
#pragma unroll
        for (int ai = 0; ai < 2; ++ai)
#pragma unroll
            for (int m = 0; m < 4; ++m) { float* rowp = C + (size_t)(row0 + ai * HALF + m * 16) * ldc + col0;
#pragma unroll
                for (int bj = 0; bj < 2; ++bj)
#pragma unroll
                    for (int n = 0; n < 2; ++n) *(f32x4*)(rowp + bj * HALF + n * 16) = acc[ai][bj][m][n] + bv[bj][n]; }
    }
};
template <int ACT  > struct EpiBf16 {
    static constexpr bool PERM = true, AFTER_DRAIN = false;
    bf16_t* O; int ldc; const float* bias; int split_cols; size_t split_stride;
    __device__ __forceinline__ void operator()(const f32x4 (&acc)[2][2][4][2], const Unit& u, int wr, int wc, int fr, int fq) const {
        const int row0 = u.pm * BM + wr * 64 + fr; int colt = u.pn * BM; bf16_t* base = O;
        if (split_cols) { const int t = colt / split_cols; base += (size_t)t * split_stride; colt -= t * split_cols; }
        const int col0 = colt + wc * 32 + 8 * fq, bcol0 = u.pn * BM + wc * 32 + 8 * fq;
        f32x4 bv[2][2];
#pragma unroll
        for (int bj = 0; bj < 2; ++bj)
#pragma unroll
            for (int n = 0; n < 2; ++n) bv[bj][n] = bias ? *(const f32x4*)(bias + bcol0 + bj * HALF + 4 * n) : (f32x4){0.f, 0.f, 0.f, 0.f};
#pragma unroll
        for (int ai = 0; ai < 2; ++ai)
#pragma unroll
            for (int m = 0; m < 4; ++m) { bf16_t* rowp = base + (size_t)(row0 + ai * HALF + m * 16) * ldc + col0;
#pragma unroll
                for (int bj = 0; bj < 2; ++bj) { f32x4 v0 = acc[ai][bj][m][0] + bv[bj][0], v1 = acc[ai][bj][m][1] + bv[bj][1];
                    if (ACT == 1) { f32x2 a = gelu_pk((f32x2){v0[0], v0[1]}), b = gelu_pk((f32x2){v0[2], v0[3]}), c = gelu_pk((f32x2){v1[0], v1[1]}), d = gelu_pk((f32x2){v1[2], v1[3]});
                        v0 = (f32x4){a.x, a.y, b.x, b.y}; v1 = (f32x4){c.x, c.y, d.x, d.y}; }
                    if (ACT == 2) {
#pragma unroll
                        for (int j = 0; j < 4; ++j) { v0[j] = 0.5f * v0[j] * (1.0f + erff(v0[j] * 0.70710678f)); v1[j] = 0.5f * v1[j] * (1.0f + erff(v1[j] * 0.70710678f)); } }
                    u32x4 w; w.x = cvt_pk_bf16(v0[0], v0[1]); w.y = cvt_pk_bf16(v0[2], v0[3]); w.z = cvt_pk_bf16(v1[0], v1[1]); w.w = cvt_pk_bf16(v1[2], v1[3]);
                    *(u32x4*)(rowp + bj * HALF) = w; } }
    }
};
template <class Epi, class Sched, bool STAMP = false>
__device__ __forceinline__ void gemm_phase(PG8_LAS unsigned char* lds, const Gemm g, const Sched& S, const Epi& E, unsigned long long* stamps, const int tid_in) {
    int tid_ = tid_in; asm volatile("" : "+v"(tid_));
    const int tid = tid_, wid = __builtin_amdgcn_readfirstlane(tid >> 6), lane = tid & 63, wr = wid >> 2, wc = wid & 3, fr = lane & 15, fq = lane >> 4;
    const int K = g.K, nt = K / BK;
    int ts_lo = 0, ts_hi = 0, nts = 0; const unsigned long long rt_entry = STAMP ? (unsigned long long)wall_clock64() : 0ull;
#define PG8_STAMP() do { if (STAMP && wid == 0 && nts < 64) { const unsigned long long _c = (unsigned long long)clock64(); \
        ts_lo = (lane == nts) ? (int)(unsigned)_c : ts_lo; ts_hi = (lane == nts) ? (int)(unsigned)(_c >> 32) : ts_hi; ++nts; } } while (0)
    PG8_STAMP();
    unsigned voffA[2], voffB[2];
#pragma unroll
    for (int i = 0; i < 2; ++i) { int R, C; stage_rc(tid * 16 + i * 8192, R, C); const int Rb = Epi::PERM ? ((R & ~31) + perm32(R & 31)) : R;
        voffA[i] = (unsigned)(R * K + C) * 2u; voffB[i] = (unsigned)(Rb * K + C) * 2u; }
    const size_t kstep = (size_t)(BK * 2);
    const size_t hstep = (size_t)HALF * K * 2;
    const size_t tstep = 2 * hstep;
    const unsigned ldsw = (unsigned)wid * 1024u;
    const int aoff = lds_byte(wr * 64 + fr, fq * 8), boff = lds_byte(wc * 32 + fr, fq * 8);
#define PG8_SA(b, h) (((b) * 2 + (h)) * HTB)
#define PG8_SB(b, h) ((4 + (b) * 2 + (h)) * HTB)
#define PG8_STAGE(bufoff, gbase, voff) do { _Pragma("unroll") for (int _i = 0; _i < 2; ++_i) \
        __builtin_amdgcn_global_load_lds((const unsigned*)((const char*)(gbase) + (voff)[_i]), (PG8_LAS unsigned*)(lds + (bufoff) + ldsw + _i * 8192), 16, 0, 0); } while (0)
#define PG8_LDA(dst, b, h) do { _Pragma("unroll") for (int m = 0; m < 4; ++m) _Pragma("unroll") for (int k = 0; k < 2; ++k) dst[m][k] = *(const PG8_LAS bf16x8*)(lds + PG8_SA(b, h) + aoff + m * 2048 + k * 1024); } while (0)
#define PG8_LDB(dst, b, h) do { _Pragma("unroll") for (int n = 0; n < 2; ++n) _Pragma("unroll") for (int k = 0; k < 2; ++k) dst[n][k] = *(const PG8_LAS bf16x8*)(lds + PG8_SB(b, h) + boff + n * 2048 + k * 1024); } while (0)
#define PG8_MMA(ai, bj, At, Bt) do { __builtin_amdgcn_s_setprio(1); _Pragma("unroll") for (int m = 0; m < 4; ++m) _Pragma("unroll") for (int n = 0; n < 2; ++n) _Pragma("unroll") for (int k = 0; k < 2; ++k) \
        acc[ai][bj][m][n] = __builtin_amdgcn_mfma_f32_16x16x32_bf16(Bt[n][k], At[m][k], acc[ai][bj][m][n], 0, 0, 0); __builtin_amdgcn_s_setprio(0); } while (0)
#define PG8_WAIT_V(n) asm volatile("s_waitcnt vmcnt(" #n ")" ::: "memory")
#define PG8_WAIT_L(n) asm volatile("s_waitcnt lgkmcnt(" #n ")" ::: "memory")
#define PG8_BAR __builtin_amdgcn_s_barrier()
#define PG8_SCHED __builtin_amdgcn_sched_barrier(0)
    Unit cur, nxt; int ui = 0;
    if (!S.next(0, cur)) return;
    f32x4 acc[2][2][4][2];
#pragma unroll
    for (int a = 0; a < 2; ++a)
#pragma unroll
        for (int b = 0; b < 2; ++b)
#pragma unroll
            for (int m = 0; m < 4; ++m)
#pragma unroll
                for (int n = 0; n < 2; ++n) acc[a][b][m][n] = (f32x4){0.f, 0.f, 0.f, 0.f};
    bf16x8 At[4][2], B0[2][2], B1[2][2];
    const char* cA = (const char*)g.A + (size_t)cur.pm * tstep; const char* cB = (const char*)g.Bt + (size_t)cur.pn * tstep;
    S.a_ready(cur);
    PG8_STAGE(PG8_SB(0, 0), cB, voffB); PG8_STAGE(PG8_SA(0, 0), cA, voffA); PG8_STAGE(PG8_SB(0, 1), cB + hstep, voffB); PG8_STAGE(PG8_SA(0, 1), cA + hstep, voffA);
    if (wr == 1) PG8_BAR;
    PG8_WAIT_V(4); PG8_BAR;
    PG8_STAGE(PG8_SB(1, 0), cB + kstep, voffB); PG8_STAGE(PG8_SA(1, 0), cA + kstep, voffA); PG8_STAGE(PG8_SB(1, 1), cB + hstep + kstep, voffB);
    PG8_WAIT_V(6); PG8_BAR;
    PG8_STAMP();
    for (;;) {
        const bool has_next = S.next(ui + 1, nxt);
        const char* nA = has_next ? (const char*)g.A + (size_t)nxt.pm * tstep : cA; const char* nB = has_next ? (const char*)g.Bt + (size_t)nxt.pn * tstep : cB;
        for (int t = 0; t < nt; t += 2) {
            const bool last = (t == nt - 2);
            const char* a1 = cA + (size_t)(t + 1) * kstep;
            const char* a2 = last ? nA : cA + (size_t)(t + 2) * kstep; const char* b2 = last ? nB : cB + (size_t)(t + 2) * kstep;
            const char* a3 = a2 + kstep; const char* b3 = b2 + kstep;
            if (last && has_next) S.a_ready(nxt);
            PG8_LDB(B0, 0, 0); PG8_SCHED; PG8_LDA(At, 0, 0); PG8_STAGE(PG8_SA(1, 1), a1 + hstep, voffA);
            PG8_WAIT_L(8); PG8_BAR; PG8_WAIT_L(0); PG8_MMA(0, 0, At, B0); PG8_BAR; PG8_SCHED;
            PG8_LDB(B1, 0, 1); PG8_STAGE(PG8_SB(0, 0), b2, voffB);
            PG8_BAR; PG8_WAIT_L(0); PG8_MMA(0, 1, At, B1); PG8_BAR;
            PG8_LDA(At, 0, 1); PG8_STAGE(PG8_SA(0, 0), a2, voffA);
            PG8_BAR; PG8_WAIT_L(0); PG8_MMA(1, 0, At, B0); PG8_BAR; PG8_SCHED;
            PG8_STAGE(PG8_SB(0, 1), b2 + hstep, voffB);
            PG8_WAIT_V(6); PG8_BAR; PG8_MMA(1, 1, At, B1); PG8_BAR;
            PG8_LDB(B0, 1, 0); PG8_SCHED; PG8_LDA(At, 1, 0); PG8_STAGE(PG8_SA(0, 1), a2 + hstep, voffA);
            PG8_WAIT_L(8); PG8_BAR; PG8_WAIT_L(0); PG8_MMA(0, 0, At, B0); PG8_BAR; PG8_SCHED;
            PG8_LDB(B1, 1, 1); PG8_STAGE(PG8_SB(1, 0), b3, voffB);
            PG8_BAR; PG8_WAIT_L(0); PG8_MMA(0, 1, At, B1); PG8_BAR;
            PG8_LDA(At, 1, 1); PG8_STAGE(PG8_SA(1, 0), a3, voffA);
            PG8_BAR; PG8_WAIT_L(0); PG8_MMA(1, 0, At, B0); PG8_BAR; PG8_SCHED;
            PG8_STAGE(PG8_SB(1, 1), b3 + hstep, voffB);
            PG8_WAIT_V(6); PG8_BAR; PG8_MMA(1, 1, At, B1); PG8_BAR;
        }
        PG8_STAMP();
        if constexpr (!Epi::AFTER_DRAIN) { E(acc, cur, wr, wc, fr, fq); S.done(cur); }
        PG8_STAMP();
        if (!has_next) break;
#pragma unroll
        for (int a = 0; a < 2; ++a)
#pragma unroll
            for (int b = 0; b < 2; ++b)
#pragma unroll
                for (int m = 0; m < 4; ++m)
#pragma unroll
                    for (int n = 0; n < 2; ++n) acc[a][b][m][n] = (f32x4){0.f, 0.f, 0.f, 0.f};
        cur = nxt; cA = nA; cB = nB; ++ui;
    }
    PG8_WAIT_V(0);
    if (wr == 0) PG8_BAR;
    PG8_BAR;
    if constexpr (Epi::AFTER_DRAIN) { E.fused(acc, cur, wr, wc, fr, fq, lds, wid, lane); S.done(cur); }
    PG8_STAMP();
    if (STAMP && wid == 0) { stamps[lane] = lane < nts ? (((unsigned long long)(unsigned)ts_hi << 32) | (unsigned)ts_lo) : 0ull;
        if (lane == 62) stamps[62] = rt_entry; if (lane == 63) stamps[63] = (unsigned long long)wall_clock64(); }
#undef PG8_STAMP
#undef PG8_SA
#undef PG8_SB
#undef PG8_STAGE
#undef PG8_LDA
#undef PG8_LDB
#undef PG8_MMA
#undef PG8_WAIT_V
#undef PG8_WAIT_L
#undef PG8_BAR
#undef PG8_SCHED
}
}

namespace cg = cooperative_groups;
#define LAS __attribute__((address_space(3)))
typedef unsigned short bf16_t;
typedef short bf16x8 __attribute__((ext_vector_type(8)));
typedef float f32x4 __attribute__((ext_vector_type(4)));
typedef unsigned u32x4 __attribute__((ext_vector_type(4)));
typedef unsigned u32x2 __attribute__((ext_vector_type(2)));

constexpr int DM = 1024, NTOK = 12288, NCTX = 8192, DIN = 5632, DMIX = 1536;
constexpr int LDS_BYTES = 147456;
constexpr size_t MiB = 1u << 20;
constexpr size_t WS_CTL = 0;
constexpr size_t WS_MOD = 64 * 1024;
constexpr size_t WS_ROPE = 256 * 1024;
constexpr size_t WS_WIN = 1 * MiB;
constexpr size_t WS_WOUT = 23 * MiB;
constexpr size_t WS_PROJ = 29 * MiB;
constexpr size_t WS_OF = 161 * MiB;
constexpr size_t WS_OB = 197 * MiB;
constexpr size_t WS_END = 233 * MiB;

struct Params { const float* in[24]; float* out; unsigned char* ws; int kin, kout; };
#if defined(__HIP_DEVICE_COMPILE__)
#define GAS1 __attribute__((address_space(1)))
#else
#define GAS1
#endif
struct ParamsG { const GAS1 float* in[24]; GAS1 float* out; GAS1 unsigned char* ws; int kin, kout; };

struct Ctx {
    const float *x_prompt, *x_sample, *state_lru, *state_hgrn, *state_ret, *c, *c_ctx, *norm_g, *w_mod, *b_mod, *w_in, *conv_w, *conv_b,
        *lru_wa, *lru_ba, *lru_wx, *lru_bx, *lru_lambda, *hgrn_lb_logits, *hgrn_norm_g, *ret_decay_logit, *ret_norm_g, *w_out, *final_g;
    float* out; unsigned* ctl; float* MOD; float* ROPE; bf16_t *WIN, *WOUT, *PROJ, *OF, *OB, *XN;
};

__device__ __forceinline__ float bf2f(bf16_t b) { return __uint_as_float(((unsigned)b) << 16); }
__device__ __forceinline__ unsigned f2bf(float f) { unsigned u = __float_as_uint(f); return (u + 0x7fffu + ((u >> 16) & 1u)) >> 16; }
__device__ __forceinline__ unsigned pk2(float lo, float hi) { return f2bf(lo) | (f2bf(hi) << 16); }
__device__ __forceinline__ float frcp(float x) { return __builtin_amdgcn_rcpf(x); }
__device__ __forceinline__ int launder_v(int v) { asm volatile("" : "+v"(v)); return v; }
__device__ __forceinline__ int tid_of(int wave_s) { return launder_v(wave_s * 64 + (int)__builtin_amdgcn_mbcnt_hi(~0u, __builtin_amdgcn_mbcnt_lo(~0u, 0u))); }
__device__ __forceinline__ float wave_sum(float v) {
#pragma unroll
    for (int o = 1; o < 64; o <<= 1) v += __shfl_xor(v, o);
    return v;
}
__device__ __forceinline__ float silu_f(float x) { return x * frcp(1.f + __expf(-x)); }
__device__ __forceinline__ float sigm_f(float x) { return frcp(1.f + __expf(-x)); }

__device__ __forceinline__ void p0_transpose_item(const float* W, int K, int N, bf16_t* WT, LAS float* scr, int item, int lane) {
    const int nblk = N / 32, kb = item / nblk, nb = item % nblk, k0 = 64 * kb, n0 = 32 * nb;
#pragma unroll 8
    for (int i = 0; i < 32; ++i) { const int kk = 2 * i + (lane >> 5); scr[kk * 33 + (lane & 31)] = W[(size_t)(k0 + kk) * N + n0 + (lane & 31)]; }
    asm volatile("s_waitcnt lgkmcnt(0)" ::: "memory");
    const int c = lane & 7;
#pragma unroll
    for (int j = 0; j < 4; ++j) { const int n = (lane >> 3) + 8 * j; const LAS float* s = scr + (8 * c) * 33 + n;
        u32x4 o; o.x = pk2(s[0 * 33], s[1 * 33]); o.y = pk2(s[2 * 33], s[3 * 33]); o.z = pk2(s[4 * 33], s[5 * 33]); o.w = pk2(s[6 * 33], s[7 * 33]);
        *(u32x4*)(WT + (size_t)(n0 + n) * K + k0 + 8 * c) = o; }
    asm volatile("s_waitcnt lgkmcnt(0)" ::: "memory");
}

__device__ __forceinline__ void phase0(const Ctx& X, LAS unsigned char* sm, int tid) {
    const int lane = tid & 63, wave = tid >> 6;
    const int gw = blockIdx.x * 8 + wave, NGW = gridDim.x * 8;
    LAS float* scr = (LAS float*)(sm + wave * 8448);
    constexpr int I_IN = 16 * 176, I_OUT = 24 * 32, NIT = 2 * I_IN + 2 * I_OUT;
    for (int it = gw; it < NIT; it += NGW) {
        int r = it;
        if (r < 2 * I_IN) { const int l = r / I_IN; r -= l * I_IN; p0_transpose_item(X.w_in + (size_t)l * 1024 * 5632, 1024, 5632, X.WIN + (size_t)l * 5632 * 1024, scr, r, lane); }
        else { r -= 2 * I_IN; const int l = r / I_OUT; r -= l * I_OUT; p0_transpose_item(X.w_out + (size_t)l * 1536 * 1024, 1536, 1024, X.WOUT + (size_t)l * 1024 * 1536, scr, r, lane); }
    }
    if (blockIdx.x == 0 && tid == 0) { X.ctl[0] = 0u; X.ctl[64] = 0u; }
    if (blockIdx.x == gridDim.x - 1) {
        for (int idx = tid; idx < 2048; idx += 512) { const int pos = idx >> 5, fi = idx & 31;
            const float freq = exp2f(-(float)fi * (13.287712379549449f / 32.0f));
            const float ang = (float)pos * freq; const float rev = ang * 0.15915494309189535f; const float fr = rev - floorf(rev);
            X.ROPE[2 * idx] = __builtin_amdgcn_cosf(fr); X.ROPE[2 * idx + 1] = __builtin_amdgcn_sinf(fr); }
    }
    LAS float* sc = (LAS float*)(sm + 69632);
    LAS float* red = (LAS float*)(sm + 90112);
    for (int unit = blockIdx.x; unit < 96; unit += gridDim.x) {
        const int l = unit / 48, jb = unit % 48;
        __syncthreads();
        for (int idx = tid; idx < 5 * 1024; idx += 512) { const int c = idx >> 10, k = idx & 1023; const float v = (c == 0) ? X.c_ctx[k] : X.c[(c - 1) * 1024 + k]; sc[idx] = silu_f(v); }
        __syncthreads();
        const int col = jb * 64 + lane; float a0 = 0.f, a1 = 0.f, a2 = 0.f, a3 = 0.f, a4 = 0.f;
        const float* wp = X.w_mod + ((size_t)l * 1024 + wave * 128) * 3072 + col;
#pragma unroll 8
        for (int kk = 0; kk < 128; ++kk) { const float wv = wp[(size_t)kk * 3072]; const int k = wave * 128 + kk;
            a0 += sc[k] * wv; a1 += sc[1024 + k] * wv; a2 += sc[2048 + k] * wv; a3 += sc[3072 + k] * wv; a4 += sc[4096 + k] * wv; }
        red[(wave * 5 + 0) * 64 + lane] = a0; red[(wave * 5 + 1) * 64 + lane] = a1; red[(wave * 5 + 2) * 64 + lane] = a2; red[(wave * 5 + 3) * 64 + lane] = a3; red[(wave * 5 + 4) * 64 + lane] = a4;
        __syncthreads();
        if (tid < 320) { const int c = tid >> 6, ln = tid & 63; float s = 0.f;
#pragma unroll
            for (int g = 0; g < 8; ++g) s += red[(g * 5 + c) * 64 + ln];
            X.MOD[(size_t)(l * 5 + c) * 3072 + jb * 64 + ln] = s + X.b_mod[l * 3072 + jb * 64 + ln]; }
    }
    __syncthreads();
}

__device__ __forceinline__ void phase_xn(const Ctx& X, int l, int tid) {
    const int lane = tid & 63, wave = tid >> 6;
    const int gw = blockIdx.x * 8 + wave, NGW = gridDim.x * 8;
    for (int row = gw; row < NTOK; row += NGW) {
        const float* xr = (l == 0) ? ((row < NCTX) ? X.x_prompt + (size_t)row * DM : X.x_sample + (size_t)(row - NCTX) * DM) : X.out + (size_t)row * DM;
        const int c = (row < NCTX) ? 0 : 1 + ((row - NCTX) >> 10);
        const float* md = X.MOD + (size_t)(l * 5 + c) * 3072;
        f32x4 v[4]; float s = 0.f;
#pragma unroll
        for (int j = 0; j < 4; ++j) { v[j] = ((const f32x4*)xr)[lane + 64 * j]; s += (v[j].x * v[j].x + v[j].y * v[j].y) + (v[j].z * v[j].z + v[j].w * v[j].w); }
        const float r = rsqrtf(wave_sum(s) * (1.f / 1024.f) + 1e-6f);
#pragma unroll
        for (int j = 0; j < 4; ++j) { const int k0 = (lane + 64 * j) * 4;
            const f32x4 g = *(const f32x4*)(X.norm_g + l * 1024 + k0), sh = *(const f32x4*)(md + k0), scl = *(const f32x4*)(md + 1024 + k0);
            const f32x4 y = v[j] * r * g * (scl + 1.0f) + sh;
            u32x2 o; o.x = pk2(y.x, y.y); o.y = pk2(y.z, y.w);
            *(u32x2*)(X.XN + (size_t)row * DM + k0) = o; }
    }
}

__device__ __forceinline__ void unpack8(const u32x4 p, float (&f)[8]) {
    f[0] = __uint_as_float(p.x << 16); f[1] = __uint_as_float(p.x & 0xffff0000u); f[2] = __uint_as_float(p.y << 16); f[3] = __uint_as_float(p.y & 0xffff0000u);
    f[4] = __uint_as_float(p.z << 16); f[5] = __uint_as_float(p.z & 0xffff0000u); f[6] = __uint_as_float(p.w << 16); f[7] = __uint_as_float(p.w & 0xffff0000u);
}
__device__ __forceinline__ void phase_post(const Ctx& X, int l, int tid) {
    const int lane = tid & 63, wave = tid >> 6;
    const int gw = blockIdx.x * 8 + wave, NGW = gridDim.x * 8;
    for (int row = gw; row < NTOK; row += NGW) {
        bf16_t* of = X.OF + (size_t)row * DMIX; const bf16_t* ob = X.OB + (size_t)row * DMIX; const bf16_t* pr = X.PROJ + (size_t)row * DIN;
        const int ch0 = lane * 8;
#pragma unroll
        for (int pass = 0; pass < 3; ++pass) {
            float a[8], b[8], g[8], y[8];
            unpack8(*(const u32x4*)(of + pass * 512 + ch0), a); unpack8(*(const u32x4*)(ob + pass * 512 + ch0), b);
            const int gcol = (pass == 0) ? 512 : (pass == 1) ? 3072 : 5120;
            unpack8(*(const u32x4*)(pr + gcol + ch0), g);
            float ss = 0.f;
#pragma unroll
            for (int j = 0; j < 8; ++j) { y[j] = a[j] + b[j]; ss += y[j] * y[j]; }
            if (pass > 0) {
                ss += __shfl_xor(ss, 1); ss += __shfl_xor(ss, 2); ss += __shfl_xor(ss, 4); ss += __shfl_xor(ss, 8);
                const float rn = rsqrtf(ss * (1.f / 128.f) + 1e-6f);
                const float* ng = ((pass == 1) ? X.hgrn_norm_g : X.ret_norm_g) + l * 512 + ch0;
                const f32x4 g0 = *(const f32x4*)ng, g1 = *(const f32x4*)(ng + 4);
                y[0] *= rn * g0.x; y[1] *= rn * g0.y; y[2] *= rn * g0.z; y[3] *= rn * g0.w; y[4] *= rn * g1.x; y[5] *= rn * g1.y; y[6] *= rn * g1.z; y[7] *= rn * g1.w;
            }
#pragma unroll
            for (int j = 0; j < 8; ++j) y[j] *= silu_f(g[j]);
            u32x4 o; o.x = pk2(y[0], y[1]); o.y = pk2(y[2], y[3]); o.z = pk2(y[4], y[5]); o.w = pk2(y[6], y[7]);
            *(u32x4*)(of + pass * 512 + ch0) = o;
        }
    }
}

__device__ __forceinline__ void phase_final(const Ctx& X, int tid) {
    const int lane = tid & 63, wave = tid >> 6;
    const int gw = blockIdx.x * 8 + wave, NGW = gridDim.x * 8;
    for (int row = gw; row < NTOK; row += NGW) {
        float* xr = X.out + (size_t)row * DM;
        f32x4 v[4]; float s = 0.f;
#pragma unroll
        for (int j = 0; j < 4; ++j) { v[j] = ((const f32x4*)xr)[lane + 64 * j]; s += (v[j].x * v[j].x + v[j].y * v[j].y) + (v[j].z * v[j].z + v[j].w * v[j].w); }
        const float r = rsqrtf(wave_sum(s) * (1.f / 1024.f) + 1e-6f);
#pragma unroll
        for (int j = 0; j < 4; ++j) { const f32x4 g = *(const f32x4*)(X.final_g + (lane + 64 * j) * 4); ((f32x4*)xr)[lane + 64 * j] = v[j] * r * g; }
    }
}

struct EpiResid {
    static constexpr bool PERM = false, AFTER_DRAIN = false;
    const float* xp; const float* xs; float* out; const float* modl; int layer;
    __device__ __forceinline__ void operator()(const pg8::f32x4 (&acc)[2][2][4][2], const pg8::Unit& u, int wr, int wc, int fr, int fq) const {
        const int row0 = u.pm * 256 + wr * 64 + fr, col0 = u.pn * 256 + wc * 32 + 4 * fq;
        const int c = (u.pm < 32) ? 0 : 1 + ((u.pm - 32) >> 2);
        const float* gate = modl + (size_t)c * 3072 + 2048 + col0;
        pg8::f32x4 gv[2][2];
#pragma unroll
        for (int bj = 0; bj < 2; ++bj)
#pragma unroll
            for (int n = 0; n < 2; ++n) gv[bj][n] = *(const pg8::f32x4*)(gate + bj * 128 + n * 16);
#pragma unroll
        for (int ai = 0; ai < 2; ++ai)
#pragma unroll
            for (int m = 0; m < 4; ++m) { const int row = row0 + ai * 128 + m * 16;
                const float* xr = (layer == 0) ? ((row < NCTX) ? xp + (size_t)row * DM : xs + (size_t)(row - NCTX) * DM) : out + (size_t)row * DM;
                float* orow = out + (size_t)row * DM;
#pragma unroll
                for (int bj = 0; bj < 2; ++bj)
#pragma unroll
                    for (int n = 0; n < 2; ++n) { const int cc = col0 + bj * 128 + n * 16; const pg8::f32x4 xv = *(const pg8::f32x4*)(xr + cc);
                        *(pg8::f32x4*)(orow + cc) = xv + gv[bj][n] * acc[ai][bj][m][n]; } }
    }
};

#define MFMA16(a, b, c) __builtin_amdgcn_mfma_f32_16x16x32_bf16((a), (b), (c), 0, 0, 0)
constexpr int G_QM = 0, G_QS = 17408, G_KM = 34816, G_KT = 52224, G_VT = 70656, G_ST = 89088, G_AT = 123904, G_GD = 133120, G_SEG = 133632;
constexpr int L_MISC = 140000;

__device__ __forceinline__ void gla_item(const Ctx& X, const int l, const int isdec, const int seq, const int hgl, const int dir, LAS unsigned char* sm, const int tid) {
    const int lane = tid & 63, w = __builtin_amdgcn_readfirstlane(tid >> 6);
    const int d = tid & 127, tq = w >> 1;
    const int L = isdec ? 1024 : 256, row0 = isdec ? NCTX + seq * 1024 : seq * 256, nch = L >> 6;
    const bool isret = hgl >= 4; const int h = hgl & 3;
    const int qcol = (isret ? 3584 : 1024) + h * 128 + d;
    const int zcol = (isret ? 4096 : (dir ? 2048 : 1536)) + h * 128 + d;
    const int vcol = (isret ? 4608 : 2560) + h * 128 + d;
    const int ocol = 512 + hgl * 128;
    bf16_t* OUT = dir ? X.OB : X.OF;
    float lb = 0.f, gam = 1.f;
    if (!isret) { if (l == 1) { const float a0 = X.hgrn_lb_logits[(0 * 2 + dir) * 512 + h * 128 + d], a1 = X.hgrn_lb_logits[(1 * 2 + dir) * 512 + h * 128 + d]; lb = frcp(1.f + __expf(a0 - a1)); } }
    else { gam = sigm_f(X.ret_decay_logit[(l * 2 + dir) * 4 + h]); }
    const float oml = 1.f - lb;
    const int quad = lane >> 4, r16 = lane & 15;
    const int tr = w >> 1, cbk = w & 1, dtb = 2 * (w >> 1), etb = (w & 1) * 4;
    f32x4 S[2][4];
    if (isdec) {
        const float* st = (isret ? X.state_ret : X.state_hgrn) + (size_t)((((seq * 2 + l) * 2 + dir) * 4 + h) * 128) * 128;
#pragma unroll
        for (int a = 0; a < 2; ++a)
#pragma unroll
            for (int b = 0; b < 4; ++b)
#pragma unroll
                for (int j = 0; j < 4; ++j) S[a][b][j] = st[((dtb + a) * 16 + quad * 4 + j) * 128 + (etb + b) * 16 + r16];
    } else {
#pragma unroll
        for (int a = 0; a < 2; ++a)
#pragma unroll
            for (int b = 0; b < 4; ++b) S[a][b] = (f32x4){0.f, 0.f, 0.f, 0.f};
    }
#pragma unroll
    for (int a = 0; a < 2; ++a)
#pragma unroll
        for (int b = 0; b < 4; ++b) { u32x2 o; o.x = pk2(S[a][b][0], S[a][b][1]); o.y = pk2(S[a][b][2], S[a][b][3]);
            *(LAS u32x2*)(sm + G_ST + ((etb + b) * 16 + r16) * 272 + ((dtb + a) * 16 + quad * 4) * 2) = o; }
    bf16_t rq[16], rz[16], rv[16];
    const unsigned rstride = dir ? (unsigned)(-DIN) : (unsigned)DIN;
#define GLA_LOAD(ci) do { const int cb_ = dir ? (nch - 1 - (ci)) * 64 : (ci) * 64; const int t0_ = dir ? cb_ + 63 - tq * 16 : cb_ + tq * 16; \
        unsigned ro_ = (unsigned)(row0 + t0_) * (unsigned)DIN; \
        _Pragma("unroll") for (int j = 0; j < 16; ++j) { rq[j] = X.PROJ[ro_ + (unsigned)qcol]; rz[j] = X.PROJ[ro_ + (unsigned)zcol]; rv[j] = X.PROJ[ro_ + (unsigned)vcol]; ro_ += rstride; } } while (0)
    GLA_LOAD(0);
    for (int ci = 0; ci < nch; ++ci) {
        const int cb = dir ? (nch - 1 - ci) * 64 : ci * 64;
        float cj[16], qq[16], kk[16]; float run = 1.f;
#pragma unroll
        for (int j = 0; j < 16; ++j) {
            const float qraw = bf2f(rq[j]), zraw = bf2f(rz[j]); float f, q, k;
            if (!isret) { const float e = __expf(-fmaxf(zraw, -80.f)); const float sg = frcp(1.f + e); f = fmaxf(lb + oml * sg, 1e-20f); k = oml * (e * sg); q = silu_f(qraw); }
            else { f = gam; q = qraw; k = zraw;
                if (isdec) { const int i_ = tq * 16 + j; const int t_ = dir ? cb + 63 - i_ : cb + i_; const int pos = (d < 64) ? (t_ >> 6) : (t_ & 63);
                    const float2 cs = *(const float2*)(X.ROPE + 2 * (pos * 32 + (d & 31)));
                    const float qo = __shfl_xor(q, 32), ko = __shfl_xor(k, 32);
                    if ((d & 32) == 0) { q = q * cs.x - qo * cs.y; k = k * cs.x - ko * cs.y; } else { q = qo * cs.y + q * cs.x; k = ko * cs.y + k * cs.x; } }
                q *= 0.08838834764831845f; }
            run *= f; cj[j] = run; qq[j] = q; kk[j] = k;
        }
        *(LAS float*)(sm + G_SEG + (tq * 128 + d) * 4) = run;
        __syncthreads();
        {
            const float T0 = *(LAS float*)(sm + G_SEG + (0 * 128 + d) * 4), T1 = *(LAS float*)(sm + G_SEG + (1 * 128 + d) * 4),
                        T2 = *(LAS float*)(sm + G_SEG + (2 * 128 + d) * 4), T3 = *(LAS float*)(sm + G_SEG + (3 * 128 + d) * 4);
            const float Eref = T0 * T1, E23 = T2 * T3;
            const float Mq = (tq == 0) ? 1.f / Eref : (tq == 1) ? 1.f / T1 : (tq == 2) ? 1.f : T2;
            if (tq == 0) *(LAS float*)(sm + G_GD + d * 4) = Eref * E23;
            unsigned ktp[8], vtp[8];
#pragma unroll
            for (int j = 0; j < 16; ++j) { const int i_ = tq * 16 + j;
                const float P = cj[j] * Mq; const float qm = qq[j] * P; const float km = kk[j] * frcp(P); const float ks = km * E23; const float qs = qm * Eref;
                *(LAS bf16_t*)(sm + G_QM + i_ * 272 + d * 2) = (bf16_t)f2bf(qm);
                *(LAS bf16_t*)(sm + G_QS + i_ * 272 + d * 2) = (bf16_t)f2bf(qs);
                *(LAS bf16_t*)(sm + G_KM + i_ * 272 + d * 2) = (bf16_t)f2bf(km);
                if (j & 1) { ktp[j >> 1] |= f2bf(ks) << 16; vtp[j >> 1] |= ((unsigned)rv[j]) << 16; } else { ktp[j >> 1] = f2bf(ks); vtp[j >> 1] = (unsigned)rv[j]; } }
            *(LAS u32x4*)(sm + G_KT + d * 144 + tq * 32) = (u32x4){ktp[0], ktp[1], ktp[2], ktp[3]};
            *(LAS u32x4*)(sm + G_KT + d * 144 + tq * 32 + 16) = (u32x4){ktp[4], ktp[5], ktp[6], ktp[7]};
            *(LAS u32x4*)(sm + G_VT + d * 144 + tq * 32) = (u32x4){vtp[0], vtp[1], vtp[2], vtp[3]};
            *(LAS u32x4*)(sm + G_VT + d * 144 + tq * 32 + 16) = (u32x4){vtp[4], vtp[5], vtp[6], vtp[7]};
        }
        if (ci + 1 < nch) GLA_LOAD(ci + 1);
        __syncthreads();
        f32x4 O[4];
        {
            bf16x8 aq[4];
#pragma unroll
            for (int ks = 0; ks < 4; ++ks) aq[ks] = *(LAS bf16x8*)(sm + G_QM + (tr * 16 + r16) * 272 + (ks * 32 + quad * 8) * 2);
#pragma unroll
            for (int tt = 0; tt < 2; ++tt) { const int tc = cbk * 2 + tt; f32x4 acc = (f32x4){0.f, 0.f, 0.f, 0.f};
                if (tc <= tr) {
#pragma unroll
                    for (int ks = 0; ks < 4; ++ks) { const bf16x8 bfr = *(LAS bf16x8*)(sm + G_KM + (tc * 16 + r16) * 272 + (ks * 32 + quad * 8) * 2); acc = MFMA16(aq[ks], bfr, acc); } }
#pragma unroll
                for (int j = 0; j < 4; ++j) { const int row = tr * 16 + quad * 4 + j, col = tc * 16 + r16; const float v = (col <= row) ? acc[j] : 0.f;
                    *(LAS bf16_t*)(sm + G_AT + row * 144 + col * 2) = (bf16_t)f2bf(v); } }
#pragma unroll
            for (int ks = 0; ks < 4; ++ks) aq[ks] = *(LAS bf16x8*)(sm + G_QS + (tr * 16 + r16) * 272 + (ks * 32 + quad * 8) * 2);
#pragma unroll
            for (int b = 0; b < 4; ++b) { O[b] = (f32x4){0.f, 0.f, 0.f, 0.f};
#pragma unroll
                for (int ks = 0; ks < 4; ++ks) { const bf16x8 bfr = *(LAS bf16x8*)(sm + G_ST + ((etb + b) * 16 + r16) * 272 + (ks * 32 + quad * 8) * 2); O[b] = MFMA16(aq[ks], bfr, O[b]); } }
        }
        __syncthreads();
        {
            const int nks = (tr >= 2) ? 2 : 1;
            for (int ks = 0; ks < nks; ++ks) { const bf16x8 af = *(LAS bf16x8*)(sm + G_AT + (tr * 16 + r16) * 144 + (ks * 32 + quad * 8) * 2);
#pragma unroll
                for (int b = 0; b < 4; ++b) { const bf16x8 bfr = *(LAS bf16x8*)(sm + G_VT + ((etb + b) * 16 + r16) * 144 + (ks * 32 + quad * 8) * 2); O[b] = MFMA16(af, bfr, O[b]); } }
#pragma unroll
            for (int j = 0; j < 4; ++j) { const int i_ = tr * 16 + quad * 4 + j; const int t_ = dir ? cb + 63 - i_ : cb + i_;
                bf16_t* op = OUT + (size_t)(row0 + t_) * DMIX + ocol + etb * 16 + r16;
#pragma unroll
                for (int b = 0; b < 4; ++b) op[b * 16] = (bf16_t)f2bf(O[b][j]); }
#pragma unroll
            for (int a = 0; a < 2; ++a) { const f32x4 g4 = *(LAS f32x4*)(sm + G_GD + ((dtb + a) * 16 + quad * 4) * 4);
#pragma unroll
                for (int b = 0; b < 4; ++b) S[a][b] = S[a][b] * g4; }
#pragma unroll
            for (int ks = 0; ks < 2; ++ks) {
                bf16x8 bfr[4];
#pragma unroll
                for (int b = 0; b < 4; ++b) bfr[b] = *(LAS bf16x8*)(sm + G_VT + ((etb + b) * 16 + r16) * 144 + (ks * 32 + quad * 8) * 2);
#pragma unroll
                for (int a = 0; a < 2; ++a) { const bf16x8 af = *(LAS bf16x8*)(sm + G_KT + ((dtb + a) * 16 + r16) * 144 + (ks * 32 + quad * 8) * 2);
#pragma unroll
                    for (int b = 0; b < 4; ++b) S[a][b] = MFMA16(af, bfr[b], S[a][b]); } }
#pragma unroll
            for (int a = 0; a < 2; ++a)
#pragma unroll
                for (int b = 0; b < 4; ++b) { u32x2 o; o.x = pk2(S[a][b][0], S[a][b][1]); o.y = pk2(S[a][b][2], S[a][b][3]);
                    *(LAS u32x2*)(sm + G_ST + ((etb + b) * 16 + r16) * 272 + ((dtb + a) * 16 + quad * 4) * 2) = o; }
        }
    }
#undef GLA_LOAD
    if (!isdec) {
        float* fo = X.out + (isret ? 21037056 : 12648448) + (size_t)((((seq * 2 + l) * 2 + dir) * 4 + h) * 128) * 128;
#pragma unroll
        for (int a = 0; a < 2; ++a)
#pragma unroll
            for (int b = 0; b < 4; ++b)
#pragma unroll
                for (int j = 0; j < 4; ++j) fo[((dtb + a) * 16 + quad * 4 + j) * 128 + (etb + b) * 16 + r16] = S[a][b][j];
    }
}

constexpr int R_U = 0, R_WT = 9216, R_GT = 27648, R_SA = 61440, R_SB = 63488, R_HC = 65536;
__device__ __forceinline__ void lru_item(const Ctx& X, const int l, const int isdec, const int seq, const int hb, const int dir, LAS unsigned char* sm, const int tid) {
    const int lane = tid & 63, w = __builtin_amdgcn_readfirstlane(tid >> 6);
    const int ch = lane, tq = w;
    const int L = isdec ? 1024 : 256, row0 = isdec ? NCTX + seq * 1024 : seq * 256, nch = L >> 6;
    const int gch = hb * 64 + ch;
    bf16_t* OUT = dir ? X.OB : X.OF;
    {
        const float* wa = X.lru_wa + (size_t)(((l * 2 + dir) * 8 + hb) * 64) * 64; const float* wx = X.lru_wx + (size_t)(((l * 2 + dir) * 8 + hb) * 64) * 64;
        for (int idx = tid; idx < 8192; idx += 512) { const int which = idx >> 12, k = (idx >> 6) & 63, n = idx & 63; const float v = (which ? wx : wa)[k * 64 + n];
            *(LAS bf16_t*)(sm + R_WT + (which * 64 + n) * 144 + k * 2) = (bf16_t)f2bf(v); }
    }
    const float w0 = X.conv_w[(l * 4 + 0) * 512 + gch], w1 = X.conv_w[(l * 4 + 1) * 512 + gch], w2 = X.conv_w[(l * 4 + 2) * 512 + gch], w3 = X.conv_w[(l * 4 + 3) * 512 + gch];
    const float cbias = X.conv_b[l * 512 + gch];
    const float wq0 = dir ? w3 : 0.f, wq1 = dir ? w2 : w0, wq2 = w1, wq3 = dir ? w0 : w2, wq4 = dir ? 0.f : w3;
    const float ba = X.lru_ba[(l * 2 + dir) * 512 + gch], bx = X.lru_bx[(l * 2 + dir) * 512 + gch];
    const float lam = X.lru_lambda[(l * 2 + dir) * 512 + gch];
    const float sp = (lam > 15.f) ? __expf(-lam) : log1pf(__expf(-lam));
    if (tq == 0) *(LAS float*)(sm + R_HC + ch * 4) = isdec ? X.state_lru[((seq * 2 + l) * 2 + dir) * 512 + gch] : 0.f;
    const int quad = lane >> 4, r16 = lane & 15, tr = w >> 1, ntb = (w & 1) * 4;
    const int sgn = dir ? -1 : 1;
    bf16_t ext[12];
#define LRU_LOAD(ci) do { const int cb_ = dir ? (nch - 1 - (ci)) * 64 : (ci) * 64; const int tb_ = dir ? cb_ + 63 - tq * 8 : cb_ + tq * 8; \
        _Pragma("unroll") for (int q = 0; q < 12; ++q) { const int t_ = tb_ + sgn * (q - 2); ext[q] = (t_ >= 0 && t_ < L) ? X.PROJ[(size_t)(row0 + t_) * DIN + gch] : (bf16_t)0; } } while (0)
    LRU_LOAD(0);
    float hfin = 0.f;
    for (int ci = 0; ci < nch; ++ci) {
        const int cb = dir ? (nch - 1 - ci) * 64 : ci * 64; const int tb = dir ? cb + 63 - tq * 8 : cb + tq * 8;
        float uu[8];
        { float xe[12];
#pragma unroll
          for (int q = 0; q < 12; ++q) xe[q] = bf2f(ext[q]);
#pragma unroll
          for (int j = 0; j < 8; ++j) { uu[j] = cbias + wq0 * xe[j] + wq1 * xe[j + 1] + wq2 * xe[j + 2] + wq3 * xe[j + 3] + wq4 * xe[j + 4];
              *(LAS bf16_t*)(sm + R_U + (tq * 8 + j) * 144 + ch * 2) = (bf16_t)f2bf(uu[j]); } }
        __syncthreads();
        if (ci + 1 < nch) LRU_LOAD(ci + 1);
        {
            f32x4 acc[4];
#pragma unroll
            for (int b = 0; b < 4; ++b) acc[b] = (f32x4){0.f, 0.f, 0.f, 0.f};
#pragma unroll
            for (int ks = 0; ks < 2; ++ks) { const bf16x8 af = *(LAS bf16x8*)(sm + R_U + (tr * 16 + r16) * 144 + (ks * 32 + quad * 8) * 2);
#pragma unroll
                for (int b = 0; b < 4; ++b) { const bf16x8 bfr = *(LAS bf16x8*)(sm + R_WT + ((ntb + b) * 16 + r16) * 144 + (ks * 32 + quad * 8) * 2); acc[b] = MFMA16(af, bfr, acc[b]); } }
#pragma unroll
            for (int b = 0; b < 4; ++b)
#pragma unroll
                for (int j = 0; j < 4; ++j) *(LAS float*)(sm + R_GT + ((tr * 16 + quad * 4 + j) * 132 + (ntb + b) * 16 + r16) * 4) = acc[b][j];
        }
        __syncthreads();
        float aa[8], bb[8]; float Al = 1.f, Bl = 0.f;
#pragma unroll
        for (int j = 0; j < 8; ++j) { const int i_ = tq * 8 + j;
            const float prr = *(LAS float*)(sm + R_GT + (i_ * 132 + ch) * 4) + ba, pri = *(LAS float*)(sm + R_GT + (i_ * 132 + 64 + ch) * 4) + bx;
            const float rg = sigm_f(prr), ig = sigm_f(pri);
            const float la = -8.0f * rg * sp; const float a = __expf(la); const float b = sqrtf(-expm1f(2.0f * la)) * (ig * uu[j]);
            aa[j] = a; bb[j] = b; Al *= a; Bl = a * Bl + b; }
        *(LAS float*)(sm + R_SA + (tq * 64 + ch) * 4) = Al; *(LAS float*)(sm + R_SB + (tq * 64 + ch) * 4) = Bl;
        __syncthreads();
        float hh = *(LAS float*)(sm + R_HC + ch * 4);
        for (int s = 0; s < tq; ++s) hh = *(LAS float*)(sm + R_SA + (s * 64 + ch) * 4) * hh + *(LAS float*)(sm + R_SB + (s * 64 + ch) * 4);
#pragma unroll
        for (int j = 0; j < 8; ++j) { hh = aa[j] * hh + bb[j]; const int t_ = tb + sgn * j; OUT[(size_t)(row0 + t_) * DMIX + gch] = (bf16_t)f2bf(hh); }
        hfin = hh;
        __syncthreads();
        if (tq == 7) *(LAS float*)(sm + R_HC + ch * 4) = hh;
    }
#undef LRU_LOAD
    if (!isdec && tq == 7) X.out[12582912 + ((seq * 2 + l) * 2 + dir) * 512 + gch] = hfin;
}

__device__ __forceinline__ void phase_mixer(const Ctx& X, const int l, LAS unsigned char* sm, const int tid) {
    unsigned* ctr = X.ctl + 64 * l;
    for (;;) {
        __syncthreads();
        if (tid == 0) *(LAS unsigned*)(sm + L_MISC) = atomicAdd(ctr, 1u);
        __syncthreads();
        const int it = (int)__builtin_amdgcn_readfirstlane(*(LAS unsigned*)(sm + L_MISC));
        if (it >= 1152) break;
        __syncthreads();
        const int isdec = (it < 128) ? 1 : 0; const int k = isdec ? it : it - 128; const int per = isdec ? 64 : 512;
        const int kind = (k >= per) ? 1 : 0; const int kk = kind ? k - per : k;
        if (kind == 0) gla_item(X, l, isdec, kk >> 4, (kk >> 1) & 7, kk & 1, sm, tid);
        else lru_item(X, l, isdec, kk >> 4, (kk >> 1) & 7, kk & 1, sm, tid);
    }
}

template <class T> __device__ __forceinline__ T* as_global(T* q) {
#if defined(__HIP_DEVICE_COMPILE__)
    return (T*)(__attribute__((address_space(1))) T*)q;
#else
    return q;
#endif
}
__device__ __forceinline__ const void* kernarg_ptr() {
#if defined(__HIP_DEVICE_COMPILE__)
    return (const void*)__builtin_amdgcn_kernarg_segment_ptr();
#else
    return nullptr;
#endif
}
__device__ __forceinline__ int kernarg_int(int off) {
#if defined(__HIP_DEVICE_COMPILE__)
    return *(const __attribute__((address_space(4))) int*)((const __attribute__((address_space(4))) char*)__builtin_amdgcn_kernarg_segment_ptr() + off);
#else
    return 0;
#endif
}
__device__ __forceinline__ Ctx make_ctx() {
#if defined(__HIP_DEVICE_COMPILE__)
    const __attribute__((address_space(4))) ParamsG* kp_ = (const __attribute__((address_space(4))) ParamsG*)__builtin_amdgcn_kernarg_segment_ptr(); asm volatile("" : "+s"(kp_));
    const __attribute__((address_space(4))) ParamsG& p = *kp_;
#else
    const ParamsG pp_{}; const ParamsG& p = pp_;
#endif
    Ctx X;
    X.x_prompt = (const float*)p.in[0]; X.x_sample = (const float*)p.in[1]; X.state_lru = (const float*)p.in[2]; X.state_hgrn = (const float*)p.in[3]; X.state_ret = (const float*)p.in[4]; X.c = (const float*)p.in[5]; X.c_ctx = (const float*)p.in[6]; X.norm_g = (const float*)p.in[7];
    X.w_mod = (const float*)p.in[8]; X.b_mod = (const float*)p.in[9]; X.w_in = (const float*)p.in[10]; X.conv_w = (const float*)p.in[11]; X.conv_b = (const float*)p.in[12]; X.lru_wa = (const float*)p.in[13]; X.lru_ba = (const float*)p.in[14]; X.lru_wx = (const float*)p.in[15];
    X.lru_bx = (const float*)p.in[16]; X.lru_lambda = (const float*)p.in[17]; X.hgrn_lb_logits = (const float*)p.in[18]; X.hgrn_norm_g = (const float*)p.in[19]; X.ret_decay_logit = (const float*)p.in[20]; X.ret_norm_g = (const float*)p.in[21];
    X.w_out = (const float*)p.in[22]; X.final_g = (const float*)p.in[23]; X.out = (float*)p.out; unsigned char* ws_ = (unsigned char*)p.ws;
    X.ctl = (unsigned*)(ws_ + WS_CTL); X.MOD = (float*)(ws_ + WS_MOD); X.ROPE = (float*)(ws_ + WS_ROPE);
    X.WIN = (bf16_t*)(ws_ + WS_WIN); X.WOUT = (bf16_t*)(ws_ + WS_WOUT); X.PROJ = (bf16_t*)(ws_ + WS_PROJ); X.OF = (bf16_t*)(ws_ + WS_OF); X.OB = (bf16_t*)(ws_ + WS_OB); X.XN = (bf16_t*)(ws_ + WS_OB);

    return X;
}
template <int l> __device__ __forceinline__ void layer_phases(cg::grid_group& grid, LAS unsigned char* sm, const int wave_s) {
        { const Ctx X = make_ctx(); phase_xn(X, l, tid_of(wave_s)); }
        grid.sync();
        {
            const Ctx X = make_ctx(); const int kin = kernarg_int(208);
            pg8::Gemm g{X.XN, X.WIN + (size_t)l * DIN * DM, NTOK, DIN, kin}; pg8::StaticOrder S; S.init(NTOK, DIN, (int)gridDim.x, (int)blockIdx.x);
            pg8::EpiBf16<0> E{X.PROJ, DIN, nullptr, 0, 0};
            pg8::gemm_phase<pg8::EpiBf16<0>, pg8::StaticOrder, false>(sm, g, S, E, nullptr, tid_of(wave_s));
        }
        grid.sync();
        { const Ctx X = make_ctx(); phase_mixer(X, l, sm, tid_of(wave_s)); }
        grid.sync();
        { const Ctx X = make_ctx(); phase_post(X, l, tid_of(wave_s)); }
        grid.sync();
        {
            const Ctx X = make_ctx(); const int kout = kernarg_int(212);
            pg8::Gemm g{X.OF, X.WOUT + (size_t)l * DM * DMIX, NTOK, DM, kout}; pg8::StaticOrder S; S.init(NTOK, DM, (int)gridDim.x, (int)blockIdx.x);
            EpiResid E{X.x_prompt, X.x_sample, X.out, X.MOD + (size_t)l * 5 * 3072, l};
            pg8::gemm_phase<EpiResid, pg8::StaticOrder, false>(sm, g, S, E, nullptr, tid_of(wave_s));
        }
        grid.sync();
    }
__global__ void __launch_bounds__(512, 2) fwd_megakernel(Params p) {
    extern __shared__ __attribute__((aligned(16))) unsigned char lds[];
    cg::grid_group grid = cg::this_grid();
    LAS unsigned char* sm = (LAS unsigned char*)lds;
    const int wave_s = __builtin_amdgcn_readfirstlane(threadIdx.x >> 6);
    { const Ctx X = make_ctx(); phase0(X, sm, tid_of(wave_s)); }
    grid.sync();
    layer_phases<0>(grid, sm, wave_s);
    layer_phases<1>(grid, sm, wave_s);
    { const Ctx X = make_ctx(); phase_final(X, tid_of(wave_s)); }
}

extern "C" void kernel_launch(void* const* d_in, const int* in_sizes, int n_in, void* d_out, int out_size, void* d_ws, size_t ws_size, hipStream_t stream) {
    static int grid_blocks = 0;
    if (grid_blocks == 0) {
        int dev = 0, cus = 0, per_cu = 0;
        hipGetDevice(&dev);
        hipDeviceGetAttribute(&cus, hipDeviceAttributeMultiprocessorCount, dev);
        if (hipFuncSetAttribute((const void*)fwd_megakernel, hipFuncAttributeMaxDynamicSharedMemorySize, LDS_BYTES) != hipSuccess) { fprintf(stderr, "hipFuncSetAttribute failed\n"); }
        if (hipOccupancyMaxActiveBlocksPerMultiprocessor(&per_cu, (const void*)fwd_megakernel, 512, LDS_BYTES) != hipSuccess || per_cu < 1) { fprintf(stderr, "occupancy query: %d\n", per_cu); per_cu = 1; }
        (void)hipGetLastError();
        grid_blocks = cus * 1;
        if (ws_size < WS_END) { fprintf(stderr, "workspace too small: %zu\n", ws_size); grid_blocks = -1; }
    }
    if (grid_blocks < 0) return;
    Params p{};
    for (int i = 0; i < 24; ++i) p.in[i] = (const float*)d_in[i];
    p.out = (float*)d_out; p.ws = (unsigned char*)d_ws; p.kin = DM; p.kout = DMIX;
    void* args[] = {&p};
    hipError_t e = hipLaunchCooperativeKernel((const void*)fwd_megakernel, dim3(grid_blocks), dim3(512), args, LDS_BYTES, stream);
    if (e != hipSuccess) fprintf(stderr, "cooperative launch failed: %s (grid %d)\n", hipGetErrorString(e), grid_blocks);
}
```

```cpp
#include <hip/hip_runtime.h>
#include <hip/hip_cooperative_groups.h>
#include <cstdio>
namespace pg8 {
#define PG8_LAS __attribute__((address_space(3)))
typedef unsigned short bf16_t;
typedef short bf16x8 __attribute__((ext_vector_type(8)));
typedef float f32x4 __attribute__((ext_vector_type(4)));
typedef unsigned u32x4 __attribute__((ext_vector_type(4)));
constexpr int BM = 256, BK = 64, HALF = 128, HTB = HALF * BK * 2  , STAGE_BYTES = 8 * HTB, NXCD = 8, WGM = 6;

__host__ __device__ __forceinline__ int lds_byte(int r, int c) { const int st = (r >> 4) * 2 + (c >> 5), rr = r & 15, cc = c & 31, ob = rr * 64 + cc * 2; return st * 1024 + (ob ^ (((ob >> 9) & 1) << 5)); }
__host__ __device__ __forceinline__ void stage_rc(int b, int& R, int& C) { const int st = b / 1024, sb = b % 1024, swz = sb ^ (((sb >> 9) & 1) << 5); R = (st >> 1) * 16 + swz / 64; C = (st & 1) * 32 + (swz % 64) / 2; }
__host__ __device__ __forceinline__ int perm32(int rho) { const int n = rho >> 4, i = rho & 15; return 8 * (i >> 2) + 4 * n + (i & 3); }

struct Unit { int pm, pn; };
struct Gemm { const bf16_t* A; const bf16_t* Bt; int M, N, K; };

struct StaticOrder {
    int nM, nN, nwg, G, c;
    __host__ __device__ void init(int M, int N, int G_, int c_) { nM = M / BM; nN = N / BM; nwg = nM * nN; G = G_; c = c_; }
    __host__ __device__ bool next(int i, Unit& u) const {
        const long L = (long)i * G + c; if (L >= nwg) return false;
        int wgid = (int)L; { const int q = nwg / NXCD, r = nwg % NXCD, xcd = wgid % NXCD, off = wgid / NXCD; wgid = (xcd < r ? xcd * (q + 1) : r * (q + 1) + (xcd - r) * q) + off; }
        const int nig = WGM * nN, gid = wgid / nig, fm = gid * WGM, gsz = (nM - fm) < WGM ? (nM - fm) : WGM;
        u.pm = fm + ((wgid % nig) % gsz); u.pn = (wgid % nig) / gsz; return true;
    }
    __device__ __forceinline__ void a_ready(const Unit&) const {}
    __device__ __forceinline__ void done(const Unit&) const {}
};
struct CountedOrder : StaticOrder {
    const unsigned* ready; unsigned need; unsigned* tmo;
    __device__ __forceinline__ void a_ready(const Unit& u) const {
        if (threadIdx.x < 64) {
            const unsigned long long t0 = __builtin_amdgcn_s_memrealtime(); unsigned polls = 0;
            while ((unsigned)__builtin_amdgcn_readfirstlane(__hip_atomic_load(ready + 64 * u.pm, __ATOMIC_RELAXED, __HIP_MEMORY_SCOPE_AGENT)) < need) {
                if ((++polls & 255u) == 0u && __builtin_amdgcn_readfirstlane(__hip_atomic_load(tmo, __ATOMIC_RELAXED, __HIP_MEMORY_SCOPE_AGENT)) != 0u) break;
                if (__builtin_amdgcn_s_memrealtime() - t0 > 2000000ull) {
                    if (threadIdx.x == 0) { unsigned expect = 0u; __hip_atomic_compare_exchange_strong(tmo + 1, &expect, 0x600u | (unsigned)(u.pm & 0xff), __ATOMIC_RELAXED, __ATOMIC_RELAXED, __HIP_MEMORY_SCOPE_AGENT); __hip_atomic_store(tmo, 1u, __ATOMIC_RELAXED, __HIP_MEMORY_SCOPE_AGENT); }
                    break; }
                __builtin_amdgcn_s_sleep(2); }
            __builtin_amdgcn_fence(__ATOMIC_ACQUIRE, "agent");
            asm volatile("s_waitcnt vmcnt(0)" ::: "memory");
        }
#if !defined(BROKEN_HOOK_NO_BARRIER)
        asm volatile("" ::: "memory"); __builtin_amdgcn_s_barrier(); asm volatile("" ::: "memory");
#endif
    }
};

typedef float cvtf2_t __attribute__((ext_vector_type(2)));
typedef __bf16 cvtb2_t __attribute__((ext_vector_type(2)));
__device__ __forceinline__ unsigned cvt_pk_bf16(float lo, float hi) { const cvtf2_t v = {lo, hi}; const cvtb2_t r = __builtin_convertvector(v, cvtb2_t); return __builtin_bit_cast(unsigned, r); }
typedef float f32x2 __attribute__((ext_vector_type(2)));
__device__ __forceinline__ f32x2 gelu_pk(f32x2 v) {
    const f32x2 av = __builtin_elementwise_abs(v), d = av * 0.2316418882f + 1.0f;
    f32x2 t; t.x = __builtin_amdgcn_rcpf(d.x); t.y = __builtin_amdgcn_rcpf(d.y);
    f32x2 q = t * 0.5307027145f + (-0.7265760135f); q = q * t + 0.7107068705f; q = q * t + (-0.142248368f); q = q * t + 0.127414796f; q = q * t;
    const f32x2 s = (v * v) * (-0.72134752044f);
    f32x2 e; e.x = __builtin_amdgcn_exp2f(s.x); e.y = __builtin_amdgcn_exp2f(s.y);
    const f32x2 m = v * (q * e), r = v - m;
    f32x2 o; o.x = v.x < 0.f ? m.x : r.x; o.y = v.y < 0.f ? m.y : r.y; return o;
}

struct EpiF32 {
    static constexpr bool PERM = false, AFTER_DRAIN = false;
    float* C; int ldc; const float* bias;
    __device__ __forceinline__ void operator()(const f32x4 (&acc)[2][2][4][2], const Unit& u, int wr, int wc, int fr, int fq) const {
        const int row0 = u.pm * BM + wr * 64 + fr, col0 = u.pn * BM + wc * 32 + 4 * fq;
        f32x4 bv[2][2];
#pragma unroll
        for (int bj = 0; bj < 2; ++bj)
#pragma unroll
            for (int n = 0; n < 2; ++n) bv[bj][n] = bias ? *(const f32x4*)(bias + col0 + bj * HALF + n * 16) : (f32x4){0.f, 0.f, 0.f, 0.f};
#pragma unroll
        for (int ai = 0; ai < 2; ++ai)
#pragma unroll
            for (int m = 0; m < 4; ++m) { float* rowp = C + (size_t)(row0 + ai * HALF + m * 16) * ldc + col0;
#pragma unroll
                for (int bj = 0; bj < 2; ++bj)
#pragma unroll
                    for (int n = 0; n < 2; ++n) *(f32x4*)(rowp + bj * HALF + n * 16) = acc[ai][bj][m][n] + bv[bj][n]; }
    }
};
template <int ACT  > struct EpiBf16 {
    static constexpr bool PERM = true, AFTER_DRAIN = false;
    bf16_t* O; int ldc; const float* bias; int split_cols; size_t split_stride;
    __device__ __forceinline__ void operator()(const f32x4 (&acc)[2][2][4][2], const Unit& u, int wr, int wc, int fr, int fq) const {
        const int row0 = u.pm * BM + wr * 64 + fr; int colt = u.pn * BM; bf16_t* base = O;
        if (split_cols) { const int t = colt / split_cols; base += (size_t)t * split_stride; colt -= t * split_cols; }
        const int col0 = colt + wc * 32 + 8 * fq, bcol0 = u.pn * BM + wc * 32 + 8 * fq;
        f32x4 bv[2][2];
#pragma unroll
        for (int bj = 0; bj < 2; ++bj)
#pragma unroll
            for (int n = 0; n < 2; ++n) bv[bj][n] = bias ? *(const f32x4*)(bias + bcol0 + bj * HALF + 4 * n) : (f32x4){0.f, 0.f, 0.f, 0.f};
#pragma unroll
        for (int ai = 0; ai < 2; ++ai)
#pragma unroll
            for (int m = 0; m < 4; ++m) { bf16_t* rowp = base + (size_t)(row0 + ai * HALF + m * 16) * ldc + col0;
#pragma unroll
                for (int bj = 0; bj < 2; ++bj) { f32x4 v0 = acc[ai][bj][m][0] + bv[bj][0], v1 = acc[ai][bj][m][1] + bv[bj][1];
                    if (ACT == 1) { f32x2 a = gelu_pk((f32x2){v0[0], v0[1]}), b = gelu_pk((f32x2){v0[2], v0[3]}), c = gelu_pk((f32x2){v1[0], v1[1]}), d = gelu_pk((f32x2){v1[2], v1[3]});
                        v0 = (f32x4){a.x, a.y, b.x, b.y}; v1 = (f32x4){c.x, c.y, d.x, d.y}; }
                    if (ACT == 2) {
#pragma unroll
                        for (int j = 0; j < 4; ++j) { v0[j] = 0.5f * v0[j] * (1.0f + erff(v0[j] * 0.70710678f)); v1[j] = 0.5f * v1[j] * (1.0f + erff(v1[j] * 0.70710678f)); } }
                    u32x4 w; w.x = cvt_pk_bf16(v0[0], v0[1]); w.y = cvt_pk_bf16(v0[2], v0[3]); w.z = cvt_pk_bf16(v1[0], v1[1]); w.w = cvt_pk_bf16(v1[2], v1[3]);
                    *(u32x4*)(rowp + bj * HALF) = w; } }
    }
};
template <class Epi, class Sched, bool STAMP = false>
__device__ __forceinline__ void gemm_phase(PG8_LAS unsigned char* lds, const Gemm g, const Sched& S, const Epi& E, unsigned long long* stamps, const int tid_in) {
    int tid_ = tid_in; asm volatile("" : "+v"(tid_));
    const int tid = tid_, wid = __builtin_amdgcn_readfirstlane(tid >> 6), lane = tid & 63, wr = wid >> 2, wc = wid & 3, fr = lane & 15, fq = lane >> 4;
    const int K = g.K, nt = K / BK;
    int ts_lo = 0, ts_hi = 0, nts = 0; const unsigned long long rt_entry = STAMP ? (unsigned long long)wall_clock64() : 0ull;
#define PG8_STAMP() do { if (STAMP && wid == 0 && nts < 64) { const unsigned long long _c = (unsigned long long)clock64(); \
        ts_lo = (lane == nts) ? (int)(unsigned)_c : ts_lo; ts_hi = (lane == nts) ? (int)(unsigned)(_c >> 32) : ts_hi; ++nts; } } while (0)
    PG8_STAMP();
    unsigned voffA[2], voffB[2];
#pragma unroll
    for (int i = 0; i < 2; ++i) { int R, C; stage_rc(tid * 16 + i * 8192, R, C); const int Rb = Epi::PERM ? ((R & ~31) + perm32(R & 31)) : R;
        voffA[i] = (unsigned)(R * K + C) * 2u; voffB[i] = (unsigned)(Rb * K + C) * 2u; }
    const size_t kstep = (size_t)(BK * 2);
    const size_t hstep = (size_t)HALF * K * 2;
    const size_t tstep = 2 * hstep;
    const unsigned ldsw = (unsigned)wid * 1024u;
    const int aoff = lds_byte(wr * 64 + fr, fq * 8), boff = lds_byte(wc * 32 + fr, fq * 8);
#define PG8_SA(b, h) (((b) * 2 + (h)) * HTB)
#define PG8_SB(b, h) ((4 + (b) * 2 + (h)) * HTB)
#define PG8_STAGE(bufoff, gbase, voff) do { _Pragma("unroll") for (int _i = 0; _i < 2; ++_i) \
        __builtin_amdgcn_global_load_lds((const unsigned*)((const char*)(gbase) + (voff)[_i]), (PG8_LAS unsigned*)(lds + (bufoff) + ldsw + _i * 8192), 16, 0, 0); } while (0)
#define PG8_LDA(dst, b, h) do { _Pragma("unroll") for (int m = 0; m < 4; ++m) _Pragma("unroll") for (int k = 0; k < 2; ++k) dst[m][k] = *(const PG8_LAS bf16x8*)(lds + PG8_SA(b, h) + aoff + m * 2048 + k * 1024); } while (0)
#define PG8_LDB(dst, b, h) do { _Pragma("unroll") for (int n = 0; n < 2; ++n) _Pragma("unroll") for (int k = 0; k < 2; ++k) dst[n][k] = *(const PG8_LAS bf16x8*)(lds + PG8_SB(b, h) + boff + n * 2048 + k * 1024); } while (0)
#define PG8_MMA(ai, bj, At, Bt) do { __builtin_amdgcn_s_setprio(1); _Pragma("unroll") for (int m = 0; m < 4; ++m) _Pragma("unroll") for (int n = 0; n < 2; ++n) _Pragma("unroll") for (int k = 0; k < 2; ++k) \
        acc[ai][bj][m][n] = __builtin_amdgcn_mfma_f32_16x16x32_bf16(Bt[n][k], At[m][k], acc[ai][bj][m][n], 0, 0, 0); __builtin_amdgcn_s_setprio(0); } while (0)
#define PG8_WAIT_V(n) asm volatile("s_waitcnt vmcnt(" #n ")" ::: "memory")
#define PG8_WAIT_L(n) asm volatile("s_waitcnt lgkmcnt(" #n ")" ::: "memory")
#define PG8_BAR __builtin_amdgcn_s_barrier()
#define PG8_SCHED __builtin_amdgcn_sched_barrier(0)
    Unit cur, nxt; int ui = 0;
    if (!S.next(0, cur)) return;
    f32x4 acc[2][2][4][2];
#pragma unroll
    for (int a = 0; a < 2; ++a)
#pragma unroll
        for (int b = 0; b < 2; ++b)
#pragma unroll
            for (int m = 0; m < 4; ++m)
#pragma unroll
                for (int n = 0; n < 2; ++n) acc[a][b][m][n] = (f32x4){0.f, 0.f, 0.f, 0.f};
    bf16x8 At[4][2], B0[2][2], B1[2][2];
    const char* cA = (const char*)g.A + (size_t)cur.pm * tstep; const char* cB = (const char*)g.Bt + (size_t)cur.pn * tstep;
    S.a_ready(cur);
    PG8_STAGE(PG8_SB(0, 0), cB, voffB); PG8_STAGE(PG8_SA(0, 0), cA, voffA); PG8_STAGE(PG8_SB(0, 1), cB + hstep, voffB); PG8_STAGE(PG8_SA(0, 1), cA + hstep, voffA);
    if (wr == 1) PG8_BAR;
    PG8_WAIT_V(4); PG8_BAR;
    PG8_STAGE(PG8_SB(1, 0), cB + kstep, voffB); PG8_STAGE(PG8_SA(1, 0), cA + kstep, voffA); PG8_STAGE(PG8_SB(1, 1), cB + hstep + kstep, voffB);
    PG8_WAIT_V(6); PG8_BAR;
    PG8_STAMP();
    for (;;) {
        const bool has_next = S.next(ui + 1, nxt);
        const char* nA = has_next ? (const char*)g.A + (size_t)nxt.pm * tstep : cA; const char* nB = has_next ? (const char*)g.Bt + (size_t)nxt.pn * tstep : cB;
        for (int t = 0; t < nt; t += 2) {
            const bool last = (t == nt - 2);
            const char* a1 = cA + (size_t)(t + 1) * kstep;
            const char* a2 = last ? nA : cA + (size_t)(t + 2) * kstep; const char* b2 = last ? nB : cB + (size_t)(t + 2) * kstep;
            const char* a3 = a2 + kstep; const char* b3 = b2 + kstep;
            if (last && has_next) S.a_ready(nxt);
            PG8_LDB(B0, 0, 0); PG8_SCHED; PG8_LDA(At, 0, 0); PG8_STAGE(PG8_SA(1, 1), a1 + hstep, voffA);
            PG8_WAIT_L(8); PG8_BAR; PG8_WAIT_L(0); PG8_MMA(0, 0, At, B0); PG8_BAR; PG8_SCHED;
            PG8_LDB(B1, 0, 1); PG8_STAGE(PG8_SB(0, 0), b2, voffB);
            PG8_BAR; PG8_WAIT_L(0); PG8_MMA(0, 1, At, B1); PG8_BAR;
            PG8_LDA(At, 0, 1); PG8_STAGE(PG8_SA(0, 0), a2, voffA);
            PG8_BAR; PG8_WAIT_L(0); PG8_MMA(1, 0, At, B0); PG8_BAR; PG8_SCHED;
            PG8_STAGE(PG8_SB(0, 1), b2 + hstep, voffB);
            PG8_WAIT_V(6); PG8_BAR; PG8_MMA(1, 1, At, B1); PG8_BAR;
            PG8_LDB(B0, 1, 0); PG8_SCHED; PG8_LDA(At, 1, 0); PG8_STAGE(PG8_SA(0, 1), a2 + hstep, voffA);
            PG8_WAIT_L(8); PG8_BAR; PG8_WAIT_L(0); PG8_MMA(0, 0, At, B0); PG8_BAR; PG8_SCHED;
            PG8_LDB(B1, 1, 1); PG8_STAGE(PG8_SB(1, 0), b3, voffB);
            PG8_BAR; PG8_WAIT_L(0); PG8_MMA(0, 1, At, B1); PG8_BAR;
            PG8_LDA(At, 1, 1); PG8_STAGE(PG8_SA(1, 0), a3, voffA);
            PG8_BAR; PG8_WAIT_L(0); PG8_MMA(1, 0, At, B0); PG8_BAR; PG8_SCHED;
            PG8_STAGE(PG8_SB(1, 1), b3 + hstep, voffB);
            PG8_WAIT_V(6); PG8_BAR; PG8_MMA(1, 1, At, B1); PG8_BAR;
        }
        PG8_STAMP();
        if constexpr (!Epi::AFTER_DRAIN) { E(acc, cur, wr, wc, fr, fq); S.done(cur); }
        PG8_STAMP();
        if (!has_next) break;
#pragma unroll
        for (int a = 0; a < 2; ++a)
#pragma unroll
            for (int b = 0; b < 2; ++b)
#pragma unroll
                for (int m = 0; m < 4; ++m)
#pragma unroll
                    for (int n = 0; n < 2; ++n) acc[a][b][m][n] = (f32x4){0.f, 0.f, 0.f, 0.f};
        cur = nxt; cA = nA; cB = nB; ++ui;
    }
    PG8_WAIT_V(0);
    if (wr == 0) PG8_BAR;
    PG8_BAR;
    if constexpr (Epi::AFTER_DRAIN) { E.fused(acc, cur, wr, wc, fr, fq, lds, wid, lane); S.done(cur); }
    PG8_STAMP();
    if (STAMP && wid == 0) { stamps[lane] = lane < nts ? (((unsigned long long)(unsigned)ts_hi << 32) | (unsigned)ts_lo) : 0ull;
        if (lane == 62) stamps[62] = rt_entry; if (lane == 63) stamps[63] = (unsigned long long)wall_clock64(); }
#undef PG8_STAMP
#undef PG8_SA
#undef PG8_SB
#undef PG8_STAGE
#undef PG8_LDA
#undef PG8_LDB
#undef PG8_MMA
#undef PG8_WAIT_V
#undef PG8_WAIT_L
#undef PG8_BAR
#undef PG8_SCHED
}
}

namespace cg = cooperative_groups;
#define LAS __attribute__((address_space(3)))
typedef unsigned short bf16_t;
typedef short bf16x8 __attribute__((ext_vector_type(8)));
typedef float f32x4 __attribute__((ext_vector_type(4)));
typedef unsigned u32x4 __attribute__((ext_vector_type(4)));
typedef unsigned u32x2 __attribute__((ext_vector_type(2)));

constexpr int DM = 1024, NTOK = 12288, NCTX = 8192, DIN = 5632, DMIX = 1536;
constexpr int LDS_BYTES = 147456;
constexpr size_t MiB = 1u << 20;
constexpr size_t WS_CTL = 0;
constexpr size_t WS_MOD = 64 * 1024;
constexpr size_t WS_ROPE = 256 * 1024;
constexpr size_t WS_WIN = 1 * MiB;
constexpr size_t WS_WOUT = 23 * MiB;
constexpr size_t WS_PROJ = 29 * MiB;
constexpr size_t WS_OF = 161 * MiB;
constexpr size_t WS_XN = 197 * MiB;
constexpr size_t WS_OB = 213 * MiB;
constexpr size_t WS_END = 249 * MiB;

struct Params { const float* in[24]; float* out; unsigned char* ws; int kin, kout; };
#if defined(__HIP_DEVICE_COMPILE__)
#define GAS1 __attribute__((address_space(1)))
#else
#define GAS1
#endif
struct ParamsG { const GAS1 float* in[24]; GAS1 float* out; GAS1 unsigned char* ws; int kin, kout; };

struct Ctx {
    const float *x_prompt, *x_sample, *state_lru, *state_hgrn, *state_ret, *c, *c_ctx, *norm_g, *w_mod, *b_mod, *w_in, *conv_w, *conv_b,
        *lru_wa, *lru_ba, *lru_wx, *lru_bx, *lru_lambda, *hgrn_lb_logits, *hgrn_norm_g, *ret_decay_logit, *ret_norm_g, *w_out, *final_g;
    float* out; unsigned* ctl; float* MOD; float* ROPE; bf16_t *WIN, *WOUT, *PROJ, *OF, *OB, *XN;
};

__device__ __forceinline__ float bf2f(bf16_t b) { return __uint_as_float(((unsigned)b) << 16); }
typedef float cvt_f2 __attribute__((ext_vector_type(2)));
typedef __bf16 cvt_b2 __attribute__((ext_vector_type(2)));
__device__ __forceinline__ unsigned pk2(float lo, float hi) { const cvt_f2 v = {lo, hi}; const cvt_b2 r = __builtin_convertvector(v, cvt_b2); return __builtin_bit_cast(unsigned, r); }
__device__ __forceinline__ unsigned f2bf(float f) { return pk2(f, f) & 0xffffu; }
__device__ __forceinline__ float frcp(float x) { return __builtin_amdgcn_rcpf(x); }
__device__ __forceinline__ int launder_v(int v) { asm volatile("" : "+v"(v)); return v; }
__device__ __forceinline__ int tid_of(int wave_s) { int z = 0; asm volatile("" : "+v"(z));
    return launder_v(wave_s * 64 + (int)__builtin_amdgcn_mbcnt_hi(~0u, __builtin_amdgcn_mbcnt_lo(~0u, (unsigned)z))); }
__device__ __forceinline__ float wave_sum(float v) {
#pragma unroll
    for (int o = 1; o < 64; o <<= 1) v += __shfl_xor(v, o);
    return v;
}
__device__ __forceinline__ float silu_f(float x) { return x * frcp(1.f + __expf(-x)); }
__device__ __forceinline__ float sigm_f(float x) { return frcp(1.f + __expf(-x)); }

__device__ __forceinline__ void p0_transpose_item(const float* W, int K, int N, bf16_t* WT, LAS float* scr, int item, int lane) {
    const int nblk = N / 32, kb = item / nblk, nb = item % nblk, k0 = 64 * kb, n0 = 32 * nb;
    float tv[32];
#pragma unroll
    for (int i = 0; i < 32; ++i) { const int kk = 2 * i + (lane >> 5); tv[i] = W[(size_t)(k0 + kk) * N + n0 + (lane & 31)]; }
#pragma unroll
    for (int i = 0; i < 32; ++i) { const int kk = 2 * i + (lane >> 5); scr[kk * 33 + (lane & 31)] = tv[i]; }
    asm volatile("s_waitcnt lgkmcnt(0)" ::: "memory");
    const int c = lane & 7;
#pragma unroll
    for (int j = 0; j < 4; ++j) { const int n = (lane >> 3) + 8 * j; const LAS float* s = scr + (8 * c) * 33 + n;
        u32x4 o; o.x = pk2(s[0 * 33], s[1 * 33]); o.y = pk2(s[2 * 33], s[3 * 33]); o.z = pk2(s[4 * 33], s[5 * 33]); o.w = pk2(s[6 * 33], s[7 * 33]);
        *(u32x4*)(WT + (size_t)(n0 + n) * K + k0 + 8 * c) = o; }
    asm volatile("s_waitcnt lgkmcnt(0)" ::: "memory");
}

constexpr int CW_MODCNT = 256;
__device__ __forceinline__ void phase0(const Ctx& X, LAS unsigned char* sm, int tid) {
    const int lane = tid & 63, wave = tid >> 6;
    const bool split = gridDim.x > 96;
    LAS float* sc = (LAS float*)(sm + 69632);
    LAS float* red = (LAS float*)(sm + 90112);
    for (int unit = blockIdx.x; unit < 96; unit += gridDim.x) {
        const int l = unit / 48, jb = unit % 48;
        __syncthreads();
        for (int idx = tid; idx < 5 * 1024; idx += 512) { const int c = idx >> 10, k = idx & 1023; const float v = (c == 0) ? X.c_ctx[k] : X.c[(c - 1) * 1024 + k]; sc[idx] = silu_f(v); }
        __syncthreads();
        const int col = jb * 64 + lane; float a0 = 0.f, a1 = 0.f, a2 = 0.f, a3 = 0.f, a4 = 0.f;
        const float* wp = X.w_mod + ((size_t)l * 1024 + wave * 128) * 3072 + col;
#pragma unroll 16
        for (int kk = 0; kk < 128; ++kk) { const float wv = wp[(size_t)kk * 3072]; const int k = wave * 128 + kk;
            a0 += sc[k] * wv; a1 += sc[1024 + k] * wv; a2 += sc[2048 + k] * wv; a3 += sc[3072 + k] * wv; a4 += sc[4096 + k] * wv; }
        red[(wave * 5 + 0) * 64 + lane] = a0; red[(wave * 5 + 1) * 64 + lane] = a1; red[(wave * 5 + 2) * 64 + lane] = a2; red[(wave * 5 + 3) * 64 + lane] = a3; red[(wave * 5 + 4) * 64 + lane] = a4;
        __syncthreads();
        if (tid < 320) { const int c = tid >> 6, ln = tid & 63; float s = 0.f;
#pragma unroll
            for (int g = 0; g < 8; ++g) s += red[(g * 5 + c) * 64 + ln];
            X.MOD[(size_t)(l * 5 + c) * 3072 + jb * 64 + ln] = s + X.b_mod[l * 3072 + jb * 64 + ln]; }
        asm volatile("s_waitcnt vmcnt(0)" ::: "memory");
        __syncthreads();
        if (tid == 0) { __builtin_amdgcn_fence(__ATOMIC_RELEASE, "agent"); asm volatile("s_waitcnt vmcnt(0)" ::: "memory");
            __hip_atomic_fetch_add(X.ctl + CW_MODCNT, 1u, __ATOMIC_RELAXED, __HIP_MEMORY_SCOPE_AGENT); }
    }
    {
        const int first = split ? 96 : 0;
        if ((int)blockIdx.x >= first) {
            const int gw = ((int)blockIdx.x - first) * 8 + wave, NGW = ((int)gridDim.x - first) * 8;
            LAS float* scr = (LAS float*)(sm + wave * 8448);
            constexpr int I_IN = 16 * 176, I_OUT = 24 * 32, NIT = I_IN + I_OUT;
            for (int it = gw; it < NIT; it += NGW) {
                int r = it;
                if (r < I_IN) p0_transpose_item(X.w_in, 1024, 5632, X.WIN, scr, r, lane);
                else { r -= I_IN; p0_transpose_item(X.w_out, 1536, 1024, X.WOUT, scr, r, lane); }
            }
        }
    }
    if (blockIdx.x == gridDim.x - 1) {
        for (int idx = tid; idx < 2048; idx += 512) { const int pos = idx >> 5, fi = idx & 31;
            const float freq = exp2f(-(float)fi * (13.287712379549449f / 32.0f));
            const float ang = (float)pos * freq; const float rev = ang * 0.15915494309189535f; const float fr = rev - floorf(rev);
            X.ROPE[2 * idx] = __builtin_amdgcn_cosf(fr); X.ROPE[2 * idx + 1] = __builtin_amdgcn_sinf(fr); }
    }
    __syncthreads();
    if (tid == 0) { unsigned sp = 0;
        while (__hip_atomic_load(X.ctl + CW_MODCNT, __ATOMIC_RELAXED, __HIP_MEMORY_SCOPE_AGENT) < 96u) { __builtin_amdgcn_s_sleep(2); if (++sp > (1u << 22)) break; }
        __builtin_amdgcn_fence(__ATOMIC_ACQUIRE, "agent"); asm volatile("s_waitcnt vmcnt(0)" ::: "memory"); }
    __syncthreads();
}
__device__ __forceinline__ void l1_weights_idle(const Ctx& X, LAS unsigned char* sm, int tid, int idle_idx, int nidle) {
    const int lane = tid & 63, wave = tid >> 6;
    if (nidle <= 0 || idle_idx < 0) return;
    const int gw = idle_idx * 8 + wave, NGW = nidle * 8;
    LAS float* scr = (LAS float*)(sm + wave * 8448);
    constexpr int I_IN = 16 * 176, I_OUT = 24 * 32, NIT = I_IN + I_OUT;
    for (int it = gw; it < NIT; it += NGW) {
        int r = it;
        if (r < I_IN) p0_transpose_item(X.w_in + (size_t)1024 * 5632, 1024, 5632, X.WIN + (size_t)5632 * 1024, scr, r, lane);
        else { r -= I_IN; p0_transpose_item(X.w_out + (size_t)1536 * 1024, 1536, 1024, X.WOUT + (size_t)1024 * 1536, scr, r, lane); }
    }
}
__device__ __forceinline__ void phase_xn(const Ctx& X, int l, int tid, int xbase = -1) {
    const int lane = tid & 63, wave = tid >> 6;
    const int gw = blockIdx.x * 8 + wave, NGW = gridDim.x * 8;
    for (int k = 0;; ++k) {
        const int row = (xbase >= 0) ? xbase + wave * 6 + k : gw + k * NGW;
        if ((xbase >= 0) ? (k >= 6) : (row >= NTOK)) break;
        const float* xr = (l == 0) ? ((row < NCTX) ? X.x_prompt + (size_t)row * DM : X.x_sample + (size_t)(row - NCTX) * DM) : X.out + (size_t)row * DM;
        const int c = (row < NCTX) ? 0 : 1 + ((row - NCTX) >> 10);
        const float* md = X.MOD + (size_t)(l * 5 + c) * 3072;
        f32x4 v[4]; float s = 0.f;
#pragma unroll
        for (int j = 0; j < 4; ++j) { v[j] = ((const f32x4*)xr)[lane + 64 * j]; s += (v[j].x * v[j].x + v[j].y * v[j].y) + (v[j].z * v[j].z + v[j].w * v[j].w); }
        f32x4 pg[4], psh[4], pscl[4];
#pragma unroll
        for (int j = 0; j < 4; ++j) { const int k0 = (lane + 64 * j) * 4; pg[j] = *(const f32x4*)(X.norm_g + l * 1024 + k0); psh[j] = *(const f32x4*)(md + k0); pscl[j] = *(const f32x4*)(md + 1024 + k0); }
        const float r = rsqrtf(wave_sum(s) * (1.f / 1024.f) + 1e-6f);
#pragma unroll
        for (int j = 0; j < 4; ++j) { const int k0 = (lane + 64 * j) * 4;
            const f32x4 g = pg[j], sh = psh[j], scl = pscl[j];
            const f32x4 y = v[j] * r * g * (scl + 1.0f) + sh;
            u32x2 o; o.x = pk2(y.x, y.y); o.y = pk2(y.z, y.w);
            *(u32x2*)(X.XN + (size_t)row * DM + k0) = o; }
    }
}

__device__ __forceinline__ void unpack8(const u32x4 p, float (&f)[8]) {
    f[0] = __uint_as_float(p.x << 16); f[1] = __uint_as_float(p.x & 0xffff0000u); f[2] = __uint_as_float(p.y << 16); f[3] = __uint_as_float(p.y & 0xffff0000u);
    f[4] = __uint_as_float(p.z << 16); f[5] = __uint_as_float(p.z & 0xffff0000u); f[6] = __uint_as_float(p.w << 16); f[7] = __uint_as_float(p.w & 0xffff0000u);
}
__device__ __forceinline__ void phase_post(const Ctx& X, int l, int tid, int xbase = -1) {
    const int lane = tid & 63, wave = tid >> 6;
    const int gw = blockIdx.x * 8 + wave, NGW = gridDim.x * 8;
    for (int k = 0;; ++k) {
        const int row = (xbase >= 0) ? xbase + wave * 6 + k : gw + k * NGW;
        if ((xbase >= 0) ? (k >= 6) : (row >= NTOK)) break;
        bf16_t* of = X.OF + (size_t)row * DMIX; const bf16_t* ob = X.OB + (size_t)row * DMIX; const bf16_t* pr = X.PROJ + (size_t)row * DIN;
        const int ch0 = lane * 8;
        u32x4 la[3], lb2[3], lg[3];
#pragma unroll
        for (int pass = 0; pass < 3; ++pass) { const int gcol = (pass == 0) ? 512 : (pass == 1) ? 3072 : 5120;
            la[pass] = *(const u32x4*)(of + pass * 512 + ch0); lb2[pass] = *(const u32x4*)(ob + pass * 512 + ch0); lg[pass] = *(const u32x4*)(pr + gcol + ch0); }
#pragma unroll
        for (int pass = 0; pass < 3; ++pass) {
            float a[8], b[8], g[8], y[8];
            unpack8(la[pass], a); unpack8(lb2[pass], b); unpack8(lg[pass], g);
            float ss = 0.f;
#pragma unroll
            for (int j = 0; j < 8; ++j) { y[j] = a[j] + b[j]; ss += y[j] * y[j]; }
            if (pass > 0) {
                ss += __shfl_xor(ss, 1); ss += __shfl_xor(ss, 2); ss += __shfl_xor(ss, 4); ss += __shfl_xor(ss, 8);
                const float rn = rsqrtf(ss * (1.f / 128.f) + 1e-6f);
                const float* ng = ((pass == 1) ? X.hgrn_norm_g : X.ret_norm_g) + l * 512 + ch0;
                const f32x4 g0 = *(const f32x4*)ng, g1 = *(const f32x4*)(ng + 4);
                y[0] *= rn * g0.x; y[1] *= rn * g0.y; y[2] *= rn * g0.z; y[3] *= rn * g0.w; y[4] *= rn * g1.x; y[5] *= rn * g1.y; y[6] *= rn * g1.z; y[7] *= rn * g1.w;
            }
#pragma unroll
            for (int j = 0; j < 8; ++j) y[j] *= (pass == 2 && ch0 >= 256 && row < NCTX) ? silu_f(g[j]) : g[j];
            u32x4 o; o.x = pk2(y[0], y[1]); o.y = pk2(y[2], y[3]); o.z = pk2(y[4], y[5]); o.w = pk2(y[6], y[7]);
            *(u32x4*)(of + pass * 512 + ch0) = o;
        }
    }
}

__device__ __forceinline__ void phase_final(const Ctx& X, int tid, int xbase = -1) {
    const int lane = tid & 63, wave = tid >> 6;
    const int gw = blockIdx.x * 8 + wave, NGW = gridDim.x * 8;
    for (int k = 0;; ++k) {
        const int row = (xbase >= 0) ? xbase + wave * 6 + k : gw + k * NGW;
        if ((xbase >= 0) ? (k >= 6) : (row >= NTOK)) break;
        float* xr = X.out + (size_t)row * DM;
        f32x4 v[4]; float s = 0.f;
#pragma unroll
        for (int j = 0; j < 4; ++j) { v[j] = ((const f32x4*)xr)[lane + 64 * j]; s += (v[j].x * v[j].x + v[j].y * v[j].y) + (v[j].z * v[j].z + v[j].w * v[j].w); }
        f32x4 fg[4];
#pragma unroll
        for (int j = 0; j < 4; ++j) fg[j] = *(const f32x4*)(X.final_g + (lane + 64 * j) * 4);
        const float r = rsqrtf(wave_sum(s) * (1.f / 1024.f) + 1e-6f);
#pragma unroll
        for (int j = 0; j < 4; ++j) ((f32x4*)xr)[lane + 64 * j] = v[j] * r * fg[j];
    }
}

struct EpiResid {
    static constexpr bool PERM = false, AFTER_DRAIN = false;
    const float* xp; const float* xs; float* out; const float* modl; int layer;
    __device__ __forceinline__ void operator()(const pg8::f32x4 (&acc)[2][2][4][2], const pg8::Unit& u, int wr, int wc, int fr, int fq) const {
        const int row0 = u.pm * 256 + wr * 64 + fr, col0 = u.pn * 256 + wc * 32 + 4 * fq;
        const int c = (u.pm < 32) ? 0 : 1 + ((u.pm - 32) >> 2);
        const float* gate = modl + (size_t)c * 3072 + 2048 + col0;
        pg8::f32x4 gv[2][2];
#pragma unroll
        for (int bj = 0; bj < 2; ++bj)
#pragma unroll
            for (int n = 0; n < 2; ++n) gv[bj][n] = *(const pg8::f32x4*)(gate + bj * 128 + n * 16);
#pragma unroll
        for (int ai = 0; ai < 2; ++ai)
#pragma unroll
            for (int mp = 0; mp < 2; ++mp) {
                pg8::f32x4 xv[2][2][2];
#pragma unroll
                for (int mm = 0; mm < 2; ++mm) { const int row = row0 + ai * 128 + (mp * 2 + mm) * 16;
                    const float* xr = (layer == 0) ? ((row < NCTX) ? xp + (size_t)row * DM : xs + (size_t)(row - NCTX) * DM) : out + (size_t)row * DM;
#pragma unroll
                    for (int bj = 0; bj < 2; ++bj)
#pragma unroll
                        for (int n = 0; n < 2; ++n) xv[mm][bj][n] = *(const pg8::f32x4*)(xr + col0 + bj * 128 + n * 16); }
                asm volatile("" ::: "memory");
#pragma unroll
                for (int mm = 0; mm < 2; ++mm) { float* orow = out + (size_t)(row0 + ai * 128 + (mp * 2 + mm) * 16) * DM;
#pragma unroll
                    for (int bj = 0; bj < 2; ++bj)
#pragma unroll
                        for (int n = 0; n < 2; ++n) *(pg8::f32x4*)(orow + col0 + bj * 128 + n * 16) = xv[mm][bj][n] + gv[bj][n] * acc[ai][bj][mp * 2 + mm][n]; }
                asm volatile("" ::: "memory");
            }
    }
};

template <int FIXED_ACT> struct EpiProjT {
    static constexpr bool PERM = true, AFTER_DRAIN = false;
    bf16_t* O;
    __device__ __forceinline__ void operator()(const pg8::f32x4 (&acc)[2][2][4][2], const pg8::Unit& u, int wr, int wc, int fr, int fq) const {
        const int row0 = u.pm * 256 + wr * 64 + fr; const int col0 = u.pn * 256 + wc * 32 + 8 * fq;
        const int act = (FIXED_ACT >= 0) ? FIXED_ACT : (u.pn == 2 || u.pn == 3 || u.pn == 4 || u.pn == 5 || u.pn == 12 || u.pn == 13 || u.pn == 20 || u.pn == 21) ? 1 : (u.pn >= 6 && u.pn <= 9) ? 2 : 0;
#pragma unroll
        for (int ai = 0; ai < 2; ++ai)
#pragma unroll
            for (int m = 0; m < 4; ++m) { bf16_t* rowp = O + (size_t)(row0 + ai * 128 + m * 16) * DIN + col0;
#pragma unroll
                for (int bj = 0; bj < 2; ++bj) { pg8::f32x4 v0 = acc[ai][bj][m][0], v1 = acc[ai][bj][m][1];
                    if (act == 1) {
#pragma unroll
                        for (int j = 0; j < 4; ++j) { v0[j] = silu_f(v0[j]); v1[j] = silu_f(v1[j]); } }
                    else if (act == 2) {
#pragma unroll
                        for (int j = 0; j < 4; ++j) { v0[j] = __expf(-fmaxf(v0[j], -80.f)); v1[j] = __expf(-fmaxf(v1[j], -80.f)); } }
                    u32x4 w4; w4.x = pk2(v0[0], v0[1]); w4.y = pk2(v0[2], v0[3]); w4.z = pk2(v1[0], v1[1]); w4.w = pk2(v1[2], v1[3]);
                    *(u32x4*)(rowp + bj * 128) = w4; } }
    }
};

#define MFMA16(a, b, c) __builtin_amdgcn_mfma_f32_16x16x32_bf16((a), (b), (c), 0, 0, 0)
constexpr int G_QM = 0, G_QS = 17408, G_KM = 34816, G_KT = 52224, G_VT = 68608, G_ST = 84992, G_AT = 119808, G_GD = 129024, G_SEG = 129536;
constexpr int L_MISC = 140000;

__device__ __forceinline__ void unpack8v(const u32x4 p, float (&f)[8]) {
    f[0] = __uint_as_float(p.x << 16); f[1] = __uint_as_float(p.x & 0xffff0000u); f[2] = __uint_as_float(p.y << 16); f[3] = __uint_as_float(p.y & 0xffff0000u);
    f[4] = __uint_as_float(p.z << 16); f[5] = __uint_as_float(p.z & 0xffff0000u); f[6] = __uint_as_float(p.w << 16); f[7] = __uint_as_float(p.w & 0xffff0000u);
}
__device__ __forceinline__ u32x4 pack8v(const float (&f)[8]) { u32x4 o; o.x = pk2(f[0], f[1]); o.y = pk2(f[2], f[3]); o.z = pk2(f[4], f[5]); o.w = pk2(f[6], f[7]); return o; }

template <bool ISRET, bool ROPE> __device__ __forceinline__ void gla_item(const Ctx& X, const int l, const int isdec, const int seq, const int hgl, const int dir, LAS unsigned char* sm, const int tid, unsigned* ctr, unsigned& nxt) {
    const int lane = tid & 63, w = __builtin_amdgcn_readfirstlane(tid >> 6);
    const int c8 = lane & 15, g = lane >> 4, d0 = c8 * 8, i0 = (4 * w + g) * 2;
    const int L = isdec ? 1024 : 256, row0 = isdec ? NCTX + seq * 1024 : seq * 256, nch = L >> 6;
    constexpr bool isret = ISRET; const int h = hgl & 3;
    const unsigned qcol = (unsigned)((isret ? 3584 : 1024) + h * 128 + d0);
    const unsigned zcol = (unsigned)((isret ? 4096 : (dir ? 2048 : 1536)) + h * 128 + d0);
    const unsigned vcol = (unsigned)((isret ? 4608 : 2560) + h * 128 + d0);
    const int ocol = 512 + hgl * 128;
    bf16_t* OUT = dir ? X.OB : X.OF;
    float lbv[8]; float gam = 1.f;
#pragma unroll
    for (int c = 0; c < 8; ++c) lbv[c] = 0.f;
    if (!isret) { if (l == 1) {
#pragma unroll
            for (int c = 0; c < 8; ++c) { const float a0 = X.hgrn_lb_logits[(0 * 2 + dir) * 512 + h * 128 + d0 + c], a1 = X.hgrn_lb_logits[(1 * 2 + dir) * 512 + h * 128 + d0 + c]; lbv[c] = frcp(1.f + __expf(a0 - a1)); } } }
    else { gam = sigm_f(X.ret_decay_logit[(l * 2 + dir) * 4 + h]); }
    const float lg2 = log2f(gam), g32 = exp2f(32.0f * lg2);
    const int quad = lane >> 4, r16 = lane & 15;
    const int tr = w >> 1, cbk = w & 1, dtb = 2 * (w >> 1), etb = (w & 1) * 4;
    f32x4 S[2][4];
    if (isdec) {
        const float* st = (isret ? X.state_ret : X.state_hgrn) + (size_t)((((seq * 2 + l) * 2 + dir) * 4 + h) * 128) * 128;
#pragma unroll
        for (int a = 0; a < 2; ++a)
#pragma unroll
            for (int b = 0; b < 4; ++b)
#pragma unroll
                for (int j = 0; j < 4; ++j) S[a][b][j] = st[((dtb + a) * 16 + quad * 4 + j) * 128 + (etb + b) * 16 + r16];
    } else {
#pragma unroll
        for (int a = 0; a < 2; ++a)
#pragma unroll
            for (int b = 0; b < 4; ++b) S[a][b] = (f32x4){0.f, 0.f, 0.f, 0.f};
    }
#pragma unroll
    for (int a = 0; a < 2; ++a)
#pragma unroll
        for (int b = 0; b < 4; ++b) { u32x2 o; o.x = pk2(S[a][b][0], S[a][b][1]); o.y = pk2(S[a][b][2], S[a][b][3]);
            *(LAS u32x2*)(sm + G_ST + ((etb + b) * 16 + r16) * 272 + ((dtb + a) * 16 + quad * 4) * 2) = o; }
    u32x4 rq[2], rz[2], rv[2];
#define GLA_LOAD(ci) do { const int cb_ = dir ? (nch - 1 - (ci)) * 64 : (ci) * 64; \
        _Pragma("unroll") for (int tt = 0; tt < 2; ++tt) { const int t_ = dir ? cb_ + 63 - (i0 + tt) : cb_ + i0 + tt; const unsigned ro_ = (unsigned)(row0 + t_) * (unsigned)DIN; \
            rq[tt] = *(const u32x4*)(X.PROJ + ro_ + qcol); rz[tt] = *(const u32x4*)(X.PROJ + ro_ + zcol); rv[tt] = *(const u32x4*)(X.PROJ + ro_ + vcol); } } while (0)
    GLA_LOAD(0);
    for (int ci = 0; ci < nch; ++ci) {
        const int cb = dir ? (nch - 1 - ci) * 64 : ci * 64;
        if (ci == nch - 1 && tid == 0) nxt = atomicAdd(ctr, 1u);
        float qq[2][8], kk[2][8], cum[2][8];
        {
            float ff[2][8];
#pragma unroll
            for (int tt = 0; tt < 2; ++tt) {
                float qr[8], zr[8]; unpack8v(rq[tt], qr); unpack8v(rz[tt], zr);
                if (!isret) {
#pragma unroll
                    for (int c = 0; c < 8; ++c) { const float e = zr[c]; const float sg = frcp(1.f + e); const float oml = 1.f - lbv[c];
                        ff[tt][c] = fmaxf(lbv[c] + oml * sg, 1e-20f); kk[tt][c] = oml * (e * sg); qq[tt][c] = qr[c]; }
                } else {
                    if constexpr (ROPE) { const int t_ = dir ? cb + 63 - (i0 + tt) : cb + i0 + tt; const int pos = (c8 < 8) ? (t_ >> 6) : (t_ & 63);
                        const float* rp = X.ROPE + 2 * (pos * 32 + 8 * (c8 & 3));
                        const f32x4 cs0 = *(const f32x4*)(rp), cs1 = *(const f32x4*)(rp + 4), cs2 = *(const f32x4*)(rp + 8), cs3 = *(const f32x4*)(rp + 12);
                        const float cc[8] = {cs0.x, cs0.z, cs1.x, cs1.z, cs2.x, cs2.z, cs3.x, cs3.z}, ss[8] = {cs0.y, cs0.w, cs1.y, cs1.w, cs2.y, cs2.w, cs3.y, cs3.w};
                        const bool first = (c8 & 4) == 0;
#pragma unroll
                        for (int c = 0; c < 8; ++c) { const float qo = __shfl_xor(qr[c], 4), ko = __shfl_xor(zr[c], 4);
                            qr[c] = first ? qr[c] * cc[c] - qo * ss[c] : qo * ss[c] + qr[c] * cc[c];
                            zr[c] = first ? zr[c] * cc[c] - ko * ss[c] : ko * ss[c] + zr[c] * cc[c]; } }
                    const float pt = exp2f((float)(i0 + tt - 31) * lg2);
#pragma unroll
                    for (int c = 0; c < 8; ++c) { cum[tt][c] = pt; kk[tt][c] = zr[c]; qq[tt][c] = qr[c] * 0.08838834764831845f; }
                }
            }
            if (!isret) {
            float wt[8];
#pragma unroll
            for (int c = 0; c < 8; ++c) { const float tot = ff[0][c] * ff[1][c]; float inc = tot;
                float u = __shfl_up(inc, 16); if (g >= 1) inc *= u;
                u = __shfl_up(inc, 32); if (g >= 2) inc *= u;
                float exc = __shfl_up(inc, 16); if (g == 0) exc = 1.f;
                cum[0][c] = exc * ff[0][c]; cum[1][c] = inc; wt[c] = inc; }
            if (g == 3) { *(LAS f32x4*)(sm + G_SEG + (w * 128 + d0) * 4) = (f32x4){wt[0], wt[1], wt[2], wt[3]}; *(LAS f32x4*)(sm + G_SEG + (w * 128 + d0 + 4) * 4) = (f32x4){wt[4], wt[5], wt[6], wt[7]}; }
            }
        }
        __syncthreads();
        {
            float Eref[8], E47[8], Mq[8];
            if (isret) {
#pragma unroll
                for (int c = 0; c < 8; ++c) { Eref[c] = g32; E47[c] = g32; Mq[c] = 1.f; }
            } else {
#pragma unroll
                for (int c = 0; c < 8; ++c) { Eref[c] = 1.f; E47[c] = 1.f; Mq[c] = 1.f; }
#pragma unroll
                for (int k = 3; k >= 0; --k) { const f32x4 a = *(LAS f32x4*)(sm + G_SEG + (k * 128 + d0) * 4), b = *(LAS f32x4*)(sm + G_SEG + (k * 128 + d0 + 4) * 4);
                    Eref[0] *= a.x; Eref[1] *= a.y; Eref[2] *= a.z; Eref[3] *= a.w; Eref[4] *= b.x; Eref[5] *= b.y; Eref[6] *= b.z; Eref[7] *= b.w;
                    if (w == k) {
#pragma unroll
                        for (int c = 0; c < 8; ++c) Mq[c] = Eref[c]; } }
#pragma unroll
                for (int k = 4; k < 8; ++k) { const f32x4 a = *(LAS f32x4*)(sm + G_SEG + (k * 128 + d0) * 4), b = *(LAS f32x4*)(sm + G_SEG + (k * 128 + d0 + 4) * 4);
                    if (w == k) {
#pragma unroll
                        for (int c = 0; c < 8; ++c) Mq[c] = E47[c]; }
                    E47[0] *= a.x; E47[1] *= a.y; E47[2] *= a.z; E47[3] *= a.w; E47[4] *= b.x; E47[5] *= b.y; E47[6] *= b.z; E47[7] *= b.w; }
                if (w < 4) {
#pragma unroll
                    for (int c = 0; c < 8; ++c) Mq[c] = frcp(Mq[c]); }
            }
            if (w == 0 && g == 0) { *(LAS f32x4*)(sm + G_GD + d0 * 4) = (f32x4){Eref[0] * E47[0], Eref[1] * E47[1], Eref[2] * E47[2], Eref[3] * E47[3]};
                *(LAS f32x4*)(sm + G_GD + (d0 + 4) * 4) = (f32x4){Eref[4] * E47[4], Eref[5] * E47[5], Eref[6] * E47[6], Eref[7] * E47[7]}; }
            unsigned ktp[8], vtp[8]; float ks0[8];
#pragma unroll
            for (int tt = 0; tt < 2; ++tt) {
                float qm[8], qs[8], km[8];
#pragma unroll
                for (int c = 0; c < 8; ++c) { const float P = cum[tt][c] * Mq[c]; qm[c] = qq[tt][c] * P; qs[c] = qm[c] * Eref[c]; km[c] = kk[tt][c] * frcp(P);
                    const float ksv = km[c] * E47[c];
                    if (tt == 0) ks0[c] = ksv; else ktp[c] = pk2(ks0[c], ksv); }
                *(LAS u32x4*)(sm + G_QM + (i0 + tt) * 272 + d0 * 2) = pack8v(qm);
                *(LAS u32x4*)(sm + G_QS + (i0 + tt) * 272 + d0 * 2) = pack8v(qs);
                *(LAS u32x4*)(sm + G_KM + (i0 + tt) * 272 + d0 * 2) = pack8v(km);
            }
            {
                const unsigned a0 = rv[0].x, a1 = rv[0].y, a2 = rv[0].z, a3 = rv[0].w, b0 = rv[1].x, b1 = rv[1].y, b2 = rv[1].z, b3 = rv[1].w;
                vtp[0] = (a0 & 0xffffu) | (b0 << 16); vtp[1] = (a0 >> 16) | (b0 & 0xffff0000u); vtp[2] = (a1 & 0xffffu) | (b1 << 16); vtp[3] = (a1 >> 16) | (b1 & 0xffff0000u);
                vtp[4] = (a2 & 0xffffu) | (b2 << 16); vtp[5] = (a2 >> 16) | (b2 & 0xffff0000u); vtp[6] = (a3 & 0xffffu) | (b3 << 16); vtp[7] = (a3 >> 16) | (b3 & 0xffff0000u);
            }
            const int swz = ((w ^ (c8 & 7)) * 16) + 4 * g;
#pragma unroll
            for (int c = 0; c < 8; ++c) { *(LAS unsigned*)(sm + G_KT + (d0 + c) * 128 + swz) = ktp[c]; *(LAS unsigned*)(sm + G_VT + (d0 + c) * 128 + swz) = vtp[c]; }
        }
        if (ci + 1 < nch) GLA_LOAD(ci + 1);
        __syncthreads();
        f32x4 O[4];
        {
            bf16x8 aq[4];
#pragma unroll
            for (int ks = 0; ks < 4; ++ks) aq[ks] = *(LAS bf16x8*)(sm + G_QM + (tr * 16 + r16) * 272 + (ks * 32 + quad * 8) * 2);
#pragma unroll
            for (int tt = 0; tt < 2; ++tt) { const int tc = cbk * 2 + tt; f32x4 acc = (f32x4){0.f, 0.f, 0.f, 0.f};
                if (tc <= tr) {
#pragma unroll
                    for (int ks = 0; ks < 4; ++ks) { const bf16x8 bfr = *(LAS bf16x8*)(sm + G_KM + (tc * 16 + r16) * 272 + (ks * 32 + quad * 8) * 2); acc = MFMA16(aq[ks], bfr, acc); } }
#pragma unroll
                for (int j = 0; j < 4; ++j) { const int row = tr * 16 + quad * 4 + j, col = tc * 16 + r16; const float v = (col <= row) ? acc[j] : 0.f;
                    *(LAS bf16_t*)(sm + G_AT + row * 144 + col * 2) = (bf16_t)f2bf(v); } }
#pragma unroll
            for (int ks = 0; ks < 4; ++ks) aq[ks] = *(LAS bf16x8*)(sm + G_QS + (tr * 16 + r16) * 272 + (ks * 32 + quad * 8) * 2);
#pragma unroll
            for (int b = 0; b < 4; ++b) { O[b] = (f32x4){0.f, 0.f, 0.f, 0.f};
#pragma unroll
                for (int ks = 0; ks < 4; ++ks) { const bf16x8 afr = *(LAS bf16x8*)(sm + G_ST + ((etb + b) * 16 + r16) * 272 + (ks * 32 + quad * 8) * 2); O[b] = MFMA16(afr, aq[ks], O[b]); } }
        }
        __syncthreads();
        {
            const int nks = (tr >= 2) ? 2 : 1;
            for (int ks = 0; ks < nks; ++ks) { const bf16x8 bt = *(LAS bf16x8*)(sm + G_AT + (tr * 16 + r16) * 144 + (ks * 32 + quad * 8) * 2);
#pragma unroll
                for (int b = 0; b < 4; ++b) { const int R = (etb + b) * 16 + r16; const bf16x8 afr = *(LAS bf16x8*)(sm + G_VT + R * 128 + ((((ks * 4 + quad) ^ (R >> 3)) & 7) * 16)); O[b] = MFMA16(afr, bt, O[b]); } }
            {
                const int i_ = tr * 16 + r16; const int t_ = dir ? cb + 63 - i_ : cb + i_;
                bf16_t* op = OUT + (size_t)(row0 + t_) * DMIX + ocol + etb * 16 + quad * 4;
#pragma unroll
                for (int b = 0; b < 4; ++b) { u32x2 o; o.x = pk2(O[b][0], O[b][1]); o.y = pk2(O[b][2], O[b][3]); *(u32x2*)(op + b * 16) = o; }
            }
#pragma unroll
            for (int a = 0; a < 2; ++a) { const f32x4 g4 = *(LAS f32x4*)(sm + G_GD + ((dtb + a) * 16 + quad * 4) * 4);
#pragma unroll
                for (int b = 0; b < 4; ++b) S[a][b] = S[a][b] * g4; }
#pragma unroll
            for (int ks = 0; ks < 2; ++ks) {
                bf16x8 bfr[4];
#pragma unroll
                for (int b = 0; b < 4; ++b) { const int R = (etb + b) * 16 + r16; bfr[b] = *(LAS bf16x8*)(sm + G_VT + R * 128 + ((((ks * 4 + quad) ^ (R >> 3)) & 7) * 16)); }
#pragma unroll
                for (int a = 0; a < 2; ++a) { const int R = (dtb + a) * 16 + r16; const bf16x8 af = *(LAS bf16x8*)(sm + G_KT + R * 128 + ((((ks * 4 + quad) ^ (R >> 3)) & 7) * 16));
#pragma unroll
                    for (int b = 0; b < 4; ++b) S[a][b] = MFMA16(af, bfr[b], S[a][b]); } }
#pragma unroll
            for (int a = 0; a < 2; ++a)
#pragma unroll
                for (int b = 0; b < 4; ++b) { u32x2 o; o.x = pk2(S[a][b][0], S[a][b][1]); o.y = pk2(S[a][b][2], S[a][b][3]);
                    *(LAS u32x2*)(sm + G_ST + ((etb + b) * 16 + r16) * 272 + ((dtb + a) * 16 + quad * 4) * 2) = o; }
        }
    }
#undef GLA_LOAD
    if (!isdec) {
        float* fo = X.out + (isret ? 21037056 : 12648448) + (size_t)((((seq * 2 + l) * 2 + dir) * 4 + h) * 128) * 128;
#pragma unroll
        for (int a = 0; a < 2; ++a)
#pragma unroll
            for (int b = 0; b < 4; ++b)
#pragma unroll
                for (int j = 0; j < 4; ++j) fo[((dtb + a) * 16 + quad * 4 + j) * 128 + (etb + b) * 16 + r16] = S[a][b][j];
    }
}

constexpr int R_U = 0, R_WT = 18432, R_GT = 36864, R_SA = 104448, R_SB = 108544, R_HC = 112640;
__device__ __forceinline__ void lru_item(const Ctx& X, const int l, const int isdec, const int seq, const int hb, const int dir, LAS unsigned char* sm, const int tid, unsigned* ctr, unsigned& nxt) {
    const int lane = tid & 63, w = __builtin_amdgcn_readfirstlane(tid >> 6);
    const int ch = lane, tq = w;
    const int L = isdec ? 1024 : 256, row0 = isdec ? NCTX + seq * 1024 : seq * 256, nch = L >> 7;
    const int gch = hb * 64 + ch;
    bf16_t* OUT = dir ? X.OB : X.OF;
    {
        const float* wa = X.lru_wa + (size_t)(((l * 2 + dir) * 8 + hb) * 64) * 64; const float* wx = X.lru_wx + (size_t)(((l * 2 + dir) * 8 + hb) * 64) * 64;
        float wv[16];
#pragma unroll
        for (int q = 0; q < 16; ++q) { const int idx = tid + 512 * q; const int which = idx >> 12, k = (idx >> 6) & 63, n = idx & 63; wv[q] = (which ? wx : wa)[k * 64 + n]; }
#pragma unroll
        for (int q = 0; q < 16; ++q) { const int idx = tid + 512 * q; const int which = idx >> 12, k = (idx >> 6) & 63, n = idx & 63;
            *(LAS bf16_t*)(sm + R_WT + (which * 64 + n) * 144 + k * 2) = (bf16_t)f2bf(wv[q]); }
    }
    const float w0 = X.conv_w[(l * 4 + 0) * 512 + gch], w1 = X.conv_w[(l * 4 + 1) * 512 + gch], w2 = X.conv_w[(l * 4 + 2) * 512 + gch], w3 = X.conv_w[(l * 4 + 3) * 512 + gch];
    const float cbias = X.conv_b[l * 512 + gch];
    const float wq0 = dir ? w3 : 0.f, wq1 = dir ? w2 : w0, wq2 = w1, wq3 = dir ? w0 : w2, wq4 = dir ? 0.f : w3;
    const float ba = X.lru_ba[(l * 2 + dir) * 512 + gch], bx = X.lru_bx[(l * 2 + dir) * 512 + gch];
    const float lam = X.lru_lambda[(l * 2 + dir) * 512 + gch];
    const float sp = (lam > 15.f) ? __expf(-lam) : log1pf(__expf(-lam));
    if (tq == 0) *(LAS float*)(sm + R_HC + ch * 4) = isdec ? X.state_lru[((seq * 2 + l) * 2 + dir) * 512 + gch] : 0.f;
    const int quad = lane >> 4, r16 = lane & 15;
    const int sgn = dir ? -1 : 1;
    bf16_t ext[20];
#define LRU_LOAD(ci) do { const int cb_ = dir ? (nch - 1 - (ci)) * 128 : (ci) * 128; const int tb_ = dir ? cb_ + 127 - tq * 16 : cb_ + tq * 16; \
        _Pragma("unroll") for (int q = 0; q < 20; ++q) { const int t_ = tb_ + sgn * (q - 2); ext[q] = (t_ >= 0 && t_ < L) ? X.PROJ[(size_t)(row0 + t_) * DIN + gch] : (bf16_t)0; } } while (0)
    LRU_LOAD(0);
    __syncthreads();
    float hfin = 0.f;
    for (int ci = 0; ci < nch; ++ci) {
        if (ci == nch - 1 && tid == 0) nxt = atomicAdd(ctr, 1u);
        const int cb = dir ? (nch - 1 - ci) * 128 : ci * 128; const int tb = dir ? cb + 127 - tq * 16 : cb + tq * 16;
        const int par = ci & 1;
        float uu[16];
        { float xe[20];
#pragma unroll
          for (int q = 0; q < 20; ++q) xe[q] = bf2f(ext[q]);
          if (ci + 1 < nch) LRU_LOAD(ci + 1);
#pragma unroll
          for (int j = 0; j < 16; ++j) { uu[j] = cbias + wq0 * xe[j] + wq1 * xe[j + 1] + wq2 * xe[j + 2] + wq3 * xe[j + 3] + wq4 * xe[j + 4];
              *(LAS bf16_t*)(sm + R_U + (tq * 16 + j) * 144 + ch * 2) = (bf16_t)f2bf(uu[j]); } }
        {
            f32x4 acc[8];
#pragma unroll
            for (int b = 0; b < 8; ++b) acc[b] = (f32x4){0.f, 0.f, 0.f, 0.f};
#pragma unroll
            for (int ks = 0; ks < 2; ++ks) { const bf16x8 af = *(LAS bf16x8*)(sm + R_U + (tq * 16 + r16) * 144 + (ks * 32 + quad * 8) * 2);
#pragma unroll
                for (int b = 0; b < 8; ++b) { const bf16x8 bfr = *(LAS bf16x8*)(sm + R_WT + (b * 16 + r16) * 144 + (ks * 32 + quad * 8) * 2); acc[b] = MFMA16(af, bfr, acc[b]); } }
#pragma unroll
            for (int b = 0; b < 8; ++b)
#pragma unroll
                for (int j = 0; j < 4; ++j) *(LAS float*)(sm + R_GT + ((tq * 16 + quad * 4 + j) * 132 + b * 16 + r16) * 4) = acc[b][j];
        }
        float aa[16], bb[16]; float Al = 1.f, Bl = 0.f;
#pragma unroll
        for (int j = 0; j < 16; ++j) { const int i_ = tq * 16 + j;
            const float prr = *(LAS float*)(sm + R_GT + (i_ * 132 + ch) * 4) + ba, pri = *(LAS float*)(sm + R_GT + (i_ * 132 + 64 + ch) * 4) + bx;
            const float rg = sigm_f(prr), ig = sigm_f(pri);
            const float la = -8.0f * rg * sp; const float a = __expf(la);
            const float om = fmaf(-a, a, 1.0f);
            const float b = __builtin_amdgcn_sqrtf(om) * (ig * uu[j]);
            aa[j] = a; bb[j] = b; Al *= a; Bl = a * Bl + b; }
        *(LAS float*)(sm + R_SA + ((par * 8 + tq) * 64 + ch) * 4) = Al; *(LAS float*)(sm + R_SB + ((par * 8 + tq) * 64 + ch) * 4) = Bl;
        __syncthreads();
        float hh = *(LAS float*)(sm + R_HC + (par * 64 + ch) * 4);
        { float sa[7], sb[7];
#pragma unroll
          for (int s = 0; s < 7; ++s) { sa[s] = *(LAS float*)(sm + R_SA + ((par * 8 + s) * 64 + ch) * 4); sb[s] = *(LAS float*)(sm + R_SB + ((par * 8 + s) * 64 + ch) * 4); }
#pragma unroll
          for (int s = 0; s < 7; ++s) if (s < tq) hh = sa[s] * hh + sb[s]; }
#pragma unroll
        for (int j = 0; j < 16; ++j) { hh = aa[j] * hh + bb[j]; const int t_ = tb + sgn * j; OUT[(size_t)(row0 + t_) * DMIX + gch] = (bf16_t)f2bf(hh); }
        hfin = hh;
        if (tq == 7) *(LAS float*)(sm + R_HC + ((par ^ 1) * 64 + ch) * 4) = hh;
    }
#undef LRU_LOAD
    if (!isdec && tq == 7) X.out[12582912 + ((seq * 2 + l) * 2 + dir) * 512 + gch] = hfin;
}


struct InProjOrder : pg8::StaticOrder {
    __device__ bool next(int i, pg8::Unit& u) const {
        const long Lq = (long)i * G + c;
        if (Lq < 1008) return pg8::StaticOrder::next(i, u);
        if (Lq < 1024) { u.pm = 32 + (int)(Lq - 1008); u.pn = 21; return true; }
        return false;
    }
};
struct OneUnit {
    int pm, pn;
    __device__ bool next(int i, pg8::Unit& u) const { if (i > 0) return false; u.pm = pm; u.pn = pn; return true; }
    __device__ __forceinline__ void a_ready(const pg8::Unit&) const {}
    __device__ __forceinline__ void done(const pg8::Unit&) const {}
};
__device__ __forceinline__ void phase_mixer(const Ctx& X, const int l, LAS unsigned char* sm, const int tid, const int kin) {
    unsigned* ctr = X.ctl + 64 * l;
    if (blockIdx.x < 32 || gridDim.x < 32) {
        for (int un = (int)blockIdx.x; un < 32; un += (int)gridDim.x) {
            pg8::Gemm g{X.XN, X.WIN + (size_t)l * DIN * DM, NTOK, DIN, kin}; OneUnit S{un, 21};
            pg8::EpiBf16<0> E{X.PROJ, DIN, nullptr, 0, 0};
            pg8::gemm_phase<pg8::EpiBf16<0>, OneUnit, false>(sm, g, S, E, nullptr, launder_v(tid));
        }
    }
    __syncthreads();
    if (tid == 0) *(LAS unsigned*)(sm + L_MISC) = atomicAdd(ctr, 1u);
    __syncthreads();
    int it = (int)__builtin_amdgcn_readfirstlane(*(LAS unsigned*)(sm + L_MISC));
    while (it < 1152) {
        unsigned nxt = 0u;
        __syncthreads();
        {
            const int it2 = it;
            const int isdec = (it2 < 128) ? 1 : 0; const int k = isdec ? it2 : it2 - 128; const int per = isdec ? 64 : 512;
            const int kind = (k >= per) ? 1 : 0; const int kk = kind ? k - per : k;
            const int tid2 = launder_v(tid);
            if (kind == 0) { const int hgl_ = (kk >> 1) & 7;
                if (hgl_ < 4) gla_item<false, false>(X, l, isdec, kk >> 4, hgl_, kk & 1, sm, tid2, ctr, nxt);
                else if (isdec) gla_item<true, true>(X, l, 1, kk >> 4, hgl_, kk & 1, sm, tid2, ctr, nxt);
                else gla_item<true, false>(X, l, 0, kk >> 4, hgl_, kk & 1, sm, tid2, ctr, nxt); }
            else lru_item(X, l, isdec, kk >> 4, (kk >> 1) & 7, kk & 1, sm, tid2, ctr, nxt);
        }
        if (tid == 0) *(LAS unsigned*)(sm + L_MISC) = nxt;
        __syncthreads();
        it = (int)__builtin_amdgcn_readfirstlane(*(LAS unsigned*)(sm + L_MISC));
    }
}

#define XB_TMO      128
#define XB_XCNT(j)  (256  + 64 * (j))
#define XB_XSUB(j)  (1280 + 64 * (j))
#define XB_XGEN(j)  (2304 + 64 * (j))
#define XB_TOP      3328
#define XB_TOPGEN   3392
#define XCD_BAR_WORDS 3456
#define XB_SPIN_CAP (1u << 18)

__device__ __forceinline__ unsigned xb_ld(unsigned* p)              { return __hip_atomic_load(p, __ATOMIC_RELAXED, __HIP_MEMORY_SCOPE_AGENT); }
__device__ __forceinline__ unsigned xb_add(unsigned* p, unsigned v) { return __hip_atomic_fetch_add(p, v, __ATOMIC_RELAXED, __HIP_MEMORY_SCOPE_AGENT); }
__device__ __forceinline__ unsigned xb_xcc_id() { return (unsigned)__builtin_amdgcn_s_getreg((3 << 11) | 20) & 0xFu; }
#define XB_SPIN(cond, bar) do { unsigned _sp = 0; while (cond) { __builtin_amdgcn_s_sleep(1); \
    if ((++_sp & 255u) == 0u) { if (xb_ld(&(bar)[XB_TMO])) break; if (_sp > XB_SPIN_CAP) { atomicAdd(&(bar)[XB_TMO], 1u); break; } } } } while (0)

struct XcdBarrier {
    unsigned* bar; unsigned x;
    volatile LAS unsigned* st;
};

__device__ __forceinline__ XcdBarrier xcd_barrier_post(unsigned* bar, volatile LAS unsigned* st) {
    XcdBarrier b; b.bar = bar; b.x = xb_xcc_id(); b.st = st;
    if (threadIdx.x == 0) (void)xb_add(&bar[XB_XCNT(b.x)], 1u);
    return b;
}
__device__ __forceinline__ void xcd_barrier_complete(unsigned* bar, unsigned x, unsigned& nloc, unsigned& nx) {
    const unsigned G = gridDim.x * gridDim.y * gridDim.z;
    unsigned sum, cnt, mine, sp = 0u;
    for (;;) {
        sum = 0u; cnt = 0u; mine = 0u;
#pragma unroll
        for (unsigned j = 0; j < 16; ++j) { const unsigned c = xb_ld(&bar[XB_XCNT(j)]); sum += c; cnt += (c > 0u) ? 1u : 0u; mine = (j == x) ? c : mine; }
        if (sum == G) break;
        __builtin_amdgcn_s_sleep(1);
        if ((++sp & 255u) == 0u) { if (xb_ld(&bar[XB_TMO])) break; if (sp > XB_SPIN_CAP) { atomicAdd(&bar[XB_TMO], 1u); break; } }
    }
    nloc = mine > 0u ? mine : 1u; nx = cnt > 0u ? cnt : 1u;
}

__device__ __forceinline__ void xcd_barrier(const XcdBarrier& b) {
    asm volatile("s_waitcnt vmcnt(0)" ::: "memory");
    __syncthreads();
    if (threadIdx.x == 0) {
        unsigned* bar = b.bar;
        __builtin_amdgcn_s_waitcnt(0);
        unsigned nloc = b.st[0], nx = b.st[1];
        if (nloc == 0u) { xcd_barrier_complete(bar, b.x, nloc, nx); b.st[0] = nloc; b.st[1] = nx; }
        const unsigned old = xb_add(&bar[XB_XSUB(b.x)], 1u);
        const unsigned gen = old / nloc;
        if (old + 1u == (gen + 1u) * nloc) {
            __builtin_amdgcn_fence(__ATOMIC_RELEASE, "agent");
            asm volatile("s_waitcnt vmcnt(0)" ::: "memory");
            const unsigned og = xb_add(&bar[XB_TOP], 1u);
            const unsigned tg = og / nx;
            if (og + 1u == (tg + 1u) * nx) xb_add(&bar[XB_TOPGEN], 1u);
            else XB_SPIN(xb_ld(&bar[XB_TOPGEN]) == tg, bar);
            __builtin_amdgcn_fence(__ATOMIC_ACQUIRE, "agent");
            xb_add(&bar[XB_XGEN(b.x)], 1u);
            asm volatile("s_waitcnt vmcnt(0)" ::: "memory");
        } else {
            XB_SPIN(xb_ld(&bar[XB_XGEN(b.x)]) == gen, bar);
            __builtin_amdgcn_fence(__ATOMIC_ACQUIRE, "agent");
            asm volatile("s_waitcnt vmcnt(0)" ::: "memory");
        }
    }
    __syncthreads();
}

template <class T> __device__ __forceinline__ T* as_global(T* q) {
#if defined(__HIP_DEVICE_COMPILE__)
    return (T*)(__attribute__((address_space(1))) T*)q;
#else
    return q;
#endif
}
__device__ __forceinline__ const void* kernarg_ptr() {
#if defined(__HIP_DEVICE_COMPILE__)
    return (const void*)__builtin_amdgcn_kernarg_segment_ptr();
#else
    return nullptr;
#endif
}
__device__ __forceinline__ int kernarg_int(int off) {
#if defined(__HIP_DEVICE_COMPILE__)
    return *(const __attribute__((address_space(4))) int*)((const __attribute__((address_space(4))) char*)__builtin_amdgcn_kernarg_segment_ptr() + off);
#else
    return 0;
#endif
}
__device__ __forceinline__ Ctx make_ctx() {
#if defined(__HIP_DEVICE_COMPILE__)
    const __attribute__((address_space(4))) ParamsG* kp_ = (const __attribute__((address_space(4))) ParamsG*)__builtin_amdgcn_kernarg_segment_ptr(); asm volatile("" : "+s"(kp_));
    const __attribute__((address_space(4))) ParamsG& p = *kp_;
#else
    const ParamsG pp_{}; const ParamsG& p = pp_;
#endif
    Ctx X;
    X.x_prompt = (const float*)p.in[0]; X.x_sample = (const float*)p.in[1]; X.state_lru = (const float*)p.in[2]; X.state_hgrn = (const float*)p.in[3]; X.state_ret = (const float*)p.in[4]; X.c = (const float*)p.in[5]; X.c_ctx = (const float*)p.in[6]; X.norm_g = (const float*)p.in[7];
    X.w_mod = (const float*)p.in[8]; X.b_mod = (const float*)p.in[9]; X.w_in = (const float*)p.in[10]; X.conv_w = (const float*)p.in[11]; X.conv_b = (const float*)p.in[12]; X.lru_wa = (const float*)p.in[13]; X.lru_ba = (const float*)p.in[14]; X.lru_wx = (const float*)p.in[15];
    X.lru_bx = (const float*)p.in[16]; X.lru_lambda = (const float*)p.in[17]; X.hgrn_lb_logits = (const float*)p.in[18]; X.hgrn_norm_g = (const float*)p.in[19]; X.ret_decay_logit = (const float*)p.in[20]; X.ret_norm_g = (const float*)p.in[21];
    X.w_out = (const float*)p.in[22]; X.final_g = (const float*)p.in[23]; X.out = (float*)p.out; unsigned char* ws_ = (unsigned char*)p.ws;
    X.ctl = (unsigned*)(ws_ + WS_CTL); X.MOD = (float*)(ws_ + WS_MOD); X.ROPE = (float*)(ws_ + WS_ROPE);
    X.WIN = (bf16_t*)(ws_ + WS_WIN); X.WOUT = (bf16_t*)(ws_ + WS_WOUT); X.PROJ = (bf16_t*)(ws_ + WS_PROJ); X.OF = (bf16_t*)(ws_ + WS_OF); X.OB = (bf16_t*)(ws_ + WS_OB); X.XN = (bf16_t*)(ws_ + WS_XN);

    return X;
}

constexpr int CW_BAR = 1024;
constexpr int L_BARST = 140016;
__device__ __forceinline__ void mk_barrier(LAS unsigned char* sm) {
    const Ctx X = make_ctx();
    XcdBarrier b; b.bar = X.ctl + CW_BAR; b.x = xb_xcc_id(); b.st = (volatile LAS unsigned*)(sm + L_BARST);
    xcd_barrier(b);
}

constexpr int CW_XLOC = 4608;
constexpr int CW_XLB = 5632;
constexpr int CW_POSTDONE = 6720;
constexpr int L_XID = L_BARST + 16;
__device__ __forceinline__ void xl_barrier(unsigned* ctl, LAS unsigned char* sm, const int tid, const unsigned* extra = nullptr, const unsigned extra_target = 0u) {
    asm volatile("s_waitcnt vmcnt(0)" ::: "memory");
    __syncthreads();
    if (tid == 0) {
        unsigned* c = ctl + CW_XLB + 64 * *(LAS unsigned*)(sm + L_XID);
        const unsigned old = __hip_atomic_fetch_add(c, 1u, __ATOMIC_RELAXED, __HIP_MEMORY_SCOPE_AGENT);
        const unsigned target = (old / 32u + 1u) * 32u; unsigned sp = 0;
        for (;;) {
            const unsigned e = extra ? __hip_atomic_load(extra, __ATOMIC_RELAXED, __HIP_MEMORY_SCOPE_AGENT) : extra_target;
            const unsigned v = __hip_atomic_load(c, __ATOMIC_RELAXED, __HIP_MEMORY_SCOPE_AGENT);
            if ((v >= target && e >= extra_target) || ++sp > (1u << 22)) break;
            __builtin_amdgcn_s_sleep(1); }
        __builtin_amdgcn_fence(__ATOMIC_ACQUIRE, "agent"); asm volatile("s_waitcnt vmcnt(0)" ::: "memory");
    }
    __syncthreads();
}
struct OutOrder {
    pg8::StaticOrder so; int fast, pm, pn, has;
    __device__ bool next(int i, pg8::Unit& u) const { if (!fast) return so.next(i, u); if (i > 0 || !has) return false; u.pm = pm; u.pn = pn; return true; }
    __device__ __forceinline__ void a_ready(const pg8::Unit&) const {}
    __device__ __forceinline__ void done(const pg8::Unit&) const {}
};
template <int l> __device__ __forceinline__ void layer_phases(cg::grid_group& grid, LAS unsigned char* sm, const int wave_s) {
#define XCC_ID ((int)__builtin_amdgcn_readfirstlane(*(LAS unsigned*)(sm + L_XID)))
#define XCC_LI ((int)__builtin_amdgcn_readfirstlane(*(LAS unsigned*)(sm + L_XID + 4)))
#define XFAST (__builtin_amdgcn_readfirstlane(*(LAS unsigned*)(sm + L_XID + 8)) != 0u)
#define XBASE (XFAST ? XCC_ID * 1536 + XCC_LI * 48 : -1)
        if constexpr (l != 0) {
            if (!XFAST) {
                { const Ctx X = make_ctx(); phase_xn(X, l, tid_of(wave_s)); }
                mk_barrier(sm);
            }
        }
        {
            const Ctx X = make_ctx(); const int kin = kernarg_int(208);
            pg8::Gemm g{X.XN, X.WIN + (size_t)l * DIN * DM, NTOK, DIN, kin}; InProjOrder S; S.init(NTOK, DIN - 256, (int)gridDim.x, (int)blockIdx.x);
            EpiProjT<-1> E{X.PROJ};
            pg8::gemm_phase<EpiProjT<-1>, InProjOrder, false>(sm, g, S, E, nullptr, tid_of(wave_s));
        }
        mk_barrier(sm);
        { const Ctx X = make_ctx(); phase_mixer(X, l, sm, tid_of(wave_s), kernarg_int(208)); }
        mk_barrier(sm);
        { const Ctx X = make_ctx(); phase_post(X, l, tid_of(wave_s), XBASE); }
        if (XFAST) { const Ctx X = make_ctx(); xl_barrier(X.ctl, sm, tid_of(wave_s));
            if constexpr (l == 0) { if (tid_of(wave_s) == 0) __hip_atomic_fetch_add(X.ctl + CW_POSTDONE, 1u, __ATOMIC_RELAXED, __HIP_MEMORY_SCOPE_AGENT); }
        } else mk_barrier(sm);
        {
            const Ctx X = make_ctx(); const int kout = kernarg_int(212);
            pg8::Gemm g{X.OF, X.WOUT + (size_t)l * DM * DMIX, NTOK, DM, kout};
            OutOrder S; S.so.init(NTOK, DM, (int)gridDim.x, (int)blockIdx.x); { const int xli = XCC_LI; S.fast = XFAST ? 1 : 0; S.has = (S.fast && xli < 24) ? 1 : 0; S.pm = XCC_ID * 6 + (xli >> 2); S.pn = xli & 3; }
            EpiResid E{X.x_prompt, X.x_sample, X.out, X.MOD + (size_t)l * 5 * 3072, l};
            pg8::gemm_phase<EpiResid, OutOrder, false>(sm, g, S, E, nullptr, tid_of(wave_s));
            if constexpr (l == 0) {
                if (XFAST) { const int xli = XCC_LI; l1_weights_idle(X, sm, tid_of(wave_s), (xli >= 24) ? XCC_ID * 8 + (xli - 24) : -1, 64); }
                else if (gridDim.x > 192) l1_weights_idle(X, sm, tid_of(wave_s), (int)blockIdx.x - 192, (int)gridDim.x - 192);
                else l1_weights_idle(X, sm, tid_of(wave_s), (int)blockIdx.x, (int)gridDim.x);
            }
        }
        if (XFAST) {
            { const Ctx X = make_ctx(); if constexpr (l == 0) xl_barrier(X.ctl, sm, tid_of(wave_s), X.ctl + CW_POSTDONE, gridDim.x); else xl_barrier(X.ctl, sm, tid_of(wave_s)); }
            if constexpr (l == 0) {
                { const Ctx X = make_ctx(); phase_xn(X, 1, tid_of(wave_s), XBASE); } mk_barrier(sm); }
            else { const Ctx X = make_ctx(); phase_final(X, tid_of(wave_s), XBASE); }
        } else mk_barrier(sm);
    }
#undef XCC_ID
#undef XCC_LI
#undef XFAST
#undef XBASE
__global__ void __launch_bounds__(512, 2) fwd_megakernel(Params p) {
    extern __shared__ __attribute__((aligned(16))) unsigned char lds[];
    cg::grid_group grid = cg::this_grid();
    LAS unsigned char* sm = (LAS unsigned char*)lds;
    const int wave_s = __builtin_amdgcn_readfirstlane(threadIdx.x >> 6);
    if (threadIdx.x < 2) *(LAS unsigned*)(sm + L_BARST + 4 * threadIdx.x) = 0u;
    if (threadIdx.x == 0) { const Ctx X = make_ctx(); const unsigned x = xb_xcc_id();
        *(LAS unsigned*)(sm + L_XID) = x; *(LAS unsigned*)(sm + L_XID + 4) = __hip_atomic_fetch_add(X.ctl + CW_XLOC + 64 * x, 1u, __ATOMIC_RELAXED, __HIP_MEMORY_SCOPE_AGENT); *(LAS unsigned*)(sm + L_XID + 8) = 0u; }
    __syncthreads();
    { const Ctx X = make_ctx(); (void)xcd_barrier_post(X.ctl + CW_BAR, (volatile LAS unsigned*)(sm + L_BARST)); }
    { const Ctx X = make_ctx(); phase0(X, sm, tid_of(wave_s)); }
    { const Ctx X = make_ctx(); phase_xn(X, 0, tid_of(wave_s)); }
    mk_barrier(sm);
    if (threadIdx.x == 0) {
        const Ctx X = make_ctx(); unsigned ok = 1u, nx = 0u;
        for (int j = 0; j < 16; ++j) { const unsigned c = __hip_atomic_load(X.ctl + CW_XLOC + 64 * j, __ATOMIC_RELAXED, __HIP_MEMORY_SCOPE_AGENT); if (c) { ++nx; if (c != 32u || j >= 8) ok = 0u; } }
        if (nx != 8u || gridDim.x != 256u) ok = 0u;
        *(LAS unsigned*)(sm + L_XID + 8) = ok; }
    __syncthreads();
    layer_phases<0>(grid, sm, wave_s);
    layer_phases<1>(grid, sm, wave_s);
    if (*(LAS unsigned*)(sm + L_XID + 8) == 0u) { const Ctx X = make_ctx(); phase_final(X, tid_of(wave_s)); }
}

extern "C" void kernel_launch(void* const* d_in, const int* in_sizes, int n_in, void* d_out, int out_size, void* d_ws, size_t ws_size, hipStream_t stream) {
    static int grid_blocks = 0;
    if (grid_blocks == 0) {
        int dev = 0, cus = 0, per_cu = 0;
        hipGetDevice(&dev);
        hipDeviceGetAttribute(&cus, hipDeviceAttributeMultiprocessorCount, dev);
        if (hipFuncSetAttribute((const void*)fwd_megakernel, hipFuncAttributeMaxDynamicSharedMemorySize, LDS_BYTES) != hipSuccess) { fprintf(stderr, "hipFuncSetAttribute failed\n"); }
        if (hipOccupancyMaxActiveBlocksPerMultiprocessor(&per_cu, (const void*)fwd_megakernel, 512, LDS_BYTES) != hipSuccess || per_cu < 1) { fprintf(stderr, "occupancy query: %d\n", per_cu); per_cu = 1; }
        (void)hipGetLastError();
        grid_blocks = cus * 1;
        if (ws_size < WS_END) { fprintf(stderr, "workspace too small: %zu\n", ws_size); grid_blocks = -1; }
    }
    if (grid_blocks < 0) return;
    Params p{};
    for (int i = 0; i < 24; ++i) p.in[i] = (const float*)d_in[i];
    p.out = (float*)d_out; p.ws = (unsigned char*)d_ws; p.kin = DM; p.kout = DMIX;
    if (hipMemsetAsync((char*)d_ws + WS_CTL, 0, 64 * 1024, stream) != hipSuccess) { fprintf(stderr, "memset failed\n"); return; }
    void* args[] = {&p};
    hipError_t e = hipLaunchCooperativeKernel((const void*)fwd_megakernel, dim3(grid_blocks), dim3(512), args, LDS_BYTES, stream);
    if (e != hipSuccess) fprintf(stderr, "cooperative launch failed: %s (grid %d)\n", hipGetErrorString(e), grid_blocks);
}
```

```cpp
#include <hip/hip_runtime.h>
#include <hip/hip_cooperative_groups.h>
#include <cstdio>
namespace pg8 {
#define PG8_LAS __attribute__((address_space(3)))
typedef unsigned short bf16_t;
typedef short bf16x8 __attribute__((ext_vector_type(8)));
typedef float f32x4 __attribute__((ext_vector_type(4)));
typedef unsigned u32x4 __attribute__((ext_vector_type(4)));
constexpr int BM = 256, BK = 64, HALF = 128, HTB = HALF * BK * 2  , STAGE_BYTES = 8 * HTB, NXCD = 8, WGM = 6;

__host__ __device__ __forceinline__ int lds_byte(int r, int c) { const int st = (r >> 4) * 2 + (c >> 5), rr = r & 15, cc = c & 31, ob = rr * 64 + cc * 2; return st * 1024 + (ob ^ (((ob >> 9) & 1) << 5)); }
__host__ __device__ __forceinline__ void stage_rc(int b, int& R, int& C) { const int st = b / 1024, sb = b % 1024, swz = sb ^ (((sb >> 9) & 1) << 5); R = (st >> 1) * 16 + swz / 64; C = (st & 1) * 32 + (swz % 64) / 2; }
__host__ __device__ __forceinline__ int perm32(int rho) { const int n = rho >> 4, i = rho & 15; return 8 * (i >> 2) + 4 * n + (i & 3); }

struct Unit { int pm, pn; };
struct Gemm { const bf16_t* A; const bf16_t* Bt; int M, N, K; };

struct StaticOrder {
    int nM, nN, nwg, G, c;
    __host__ __device__ void init(int M, int N, int G_, int c_) { nM = M / BM; nN = N / BM; nwg = nM * nN; G = G_; c = c_; }
    __host__ __device__ bool next(int i, Unit& u) const {
        const long L = (long)i * G + c; if (L >= nwg) return false;
        int wgid = (int)L; { const int q = nwg / NXCD, r = nwg % NXCD, xcd = wgid % NXCD, off = wgid / NXCD; wgid = (xcd < r ? xcd * (q + 1) : r * (q + 1) + (xcd - r) * q) + off; }
        const int nig = WGM * nN, gid = wgid / nig, fm = gid * WGM, gsz = (nM - fm) < WGM ? (nM - fm) : WGM;
        u.pm = fm + ((wgid % nig) % gsz); u.pn = (wgid % nig) / gsz; return true;
    }
    __device__ __forceinline__ void a_ready(const Unit&) const {}
    __device__ __forceinline__ void done(const Unit&) const {}
};
struct CountedOrder : StaticOrder {
    const unsigned* ready; unsigned need; unsigned* tmo;
    __device__ __forceinline__ void a_ready(const Unit& u) const {
        if (threadIdx.x < 64) {
            const unsigned long long t0 = __builtin_amdgcn_s_memrealtime(); unsigned polls = 0;
            while ((unsigned)__builtin_amdgcn_readfirstlane(__hip_atomic_load(ready + 64 * u.pm, __ATOMIC_RELAXED, __HIP_MEMORY_SCOPE_AGENT)) < need) {
                if ((++polls & 255u) == 0u && __builtin_amdgcn_readfirstlane(__hip_atomic_load(tmo, __ATOMIC_RELAXED, __HIP_MEMORY_SCOPE_AGENT)) != 0u) break;
                if (__builtin_amdgcn_s_memrealtime() - t0 > 2000000ull) {
                    if (threadIdx.x == 0) { unsigned expect = 0u; __hip_atomic_compare_exchange_strong(tmo + 1, &expect, 0x600u | (unsigned)(u.pm & 0xff), __ATOMIC_RELAXED, __ATOMIC_RELAXED, __HIP_MEMORY_SCOPE_AGENT); __hip_atomic_store(tmo, 1u, __ATOMIC_RELAXED, __HIP_MEMORY_SCOPE_AGENT); }
                    break; }
                __builtin_amdgcn_s_sleep(2); }
            __builtin_amdgcn_fence(__ATOMIC_ACQUIRE, "agent");
            asm volatile("s_waitcnt vmcnt(0)" ::: "memory");
        }
#if !defined(BROKEN_HOOK_NO_BARRIER)
        asm volatile("" ::: "memory"); __builtin_amdgcn_s_barrier(); asm volatile("" ::: "memory");
#endif
    }
};

typedef float cvtf2_t __attribute__((ext_vector_type(2)));
typedef __bf16 cvtb2_t __attribute__((ext_vector_type(2)));
__device__ __forceinline__ unsigned cvt_pk_bf16(float lo, float hi) { const cvtf2_t v = {lo, hi}; const cvtb2_t r = __builtin_convertvector(v, cvtb2_t); return __builtin_bit_cast(unsigned, r); }
typedef float f32x2 __attribute__((ext_vector_type(2)));
__device__ __forceinline__ f32x2 gelu_pk(f32x2 v) {
    const f32x2 av = __builtin_elementwise_abs(v), d = av * 0.2316418882f + 1.0f;
    f32x2 t; t.x = __builtin_amdgcn_rcpf(d.x); t.y = __builtin_amdgcn_rcpf(d.y);
    f32x2 q = t * 0.5307027145f + (-0.7265760135f); q = q * t + 0.7107068705f; q = q * t + (-0.142248368f); q = q * t + 0.127414796f; q = q * t;
    const f32x2 s = (v * v) * (-0.72134752044f);
    f32x2 e; e.x = __builtin_amdgcn_exp2f(s.x); e.y = __builtin_amdgcn_exp2f(s.y);
    const f32x2 m = v * (q * e), r = v - m;
    f32x2 o; o.x = v.x < 0.f ? m.x : r.x; o.y = v.y < 0.f ? m.y : r.y; return o;
}

struct EpiF32 {
    static constexpr bool PERM = false, AFTER_DRAIN = false;
    float* C; int ldc; const float* bias;
    __device__ __forceinline__ void operator()(const f32x4 (&acc)[2][2][4][2], const Unit& u, int wr, int wc, int fr, int fq) const {
        const int row0 = u.pm * BM + wr * 64 + fr, col0 = u.pn * BM + wc * 32 + 4 * fq;
        f32x4 bv[2][2];
#pragma unroll
        for (int bj = 0; bj < 2; ++bj)
#pragma unroll
            for (int n = 0; n < 2; ++n) bv[bj][n] = bias ? *(const f32x4*)(bias + col0 + bj * HALF + n * 16) : (f32x4){0.f, 0.f, 0.f, 0.f};
#pragma unroll
        for (int ai = 0; ai < 2; ++ai)
#pragma unroll
            for (int m = 0; m < 4; ++m) { float* rowp = C + (size_t)(row0 + ai * HALF + m * 16) * ldc + col0;
#pragma unroll
                for (int bj = 0; bj < 2; ++bj)
#pragma unroll
                    for (int n = 0; n < 2; ++n) *(f32x4*)(rowp + bj * HALF + n * 16) = acc[ai][bj][m][n] + bv[bj][n]; }
    }
};
template <int ACT  > struct EpiBf16 {
    static constexpr bool PERM = true, AFTER_DRAIN = false;
    bf16_t* O; int ldc; const float* bias; int split_cols; size_t split_stride;
    __device__ __forceinline__ void operator()(const f32x4 (&acc)[2][2][4][2], const Unit& u, int wr, int wc, int fr, int fq) const {
        const int row0 = u.pm * BM + wr * 64 + fr; int colt = u.pn * BM; bf16_t* base = O;
        if (split_cols) { const int t = colt / split_cols; base += (size_t)t * split_stride; colt -= t * split_cols; }
        const int col0 = colt + wc * 32 + 8 * fq, bcol0 = u.pn * BM + wc * 32 + 8 * fq;
        f32x4 bv[2][2];
#pragma unroll
        for (int bj = 0; bj < 2; ++bj)
#pragma unroll
            for (int n = 0; n < 2; ++n) bv[bj][n] = bias ? *(const f32x4*)(bias + bcol0 + bj * HALF + 4 * n) : (f32x4){0.f, 0.f, 0.f, 0.f};
#pragma unroll
        for (int ai = 0; ai < 2; ++ai)
#pragma unroll
            for (int m = 0; m < 4; ++m) { bf16_t* rowp = base + (size_t)(row0 + ai * HALF + m * 16) * ldc + col0;
#pragma unroll
                for (int bj = 0; bj < 2; ++bj) { f32x4 v0 = acc[ai][bj][m][0] + bv[bj][0], v1 = acc[ai][bj][m][1] + bv[bj][1];
                    if (ACT == 1) { f32x2 a = gelu_pk((f32x2){v0[0], v0[1]}), b = gelu_pk((f32x2){v0[2], v0[3]}), c = gelu_pk((f32x2){v1[0], v1[1]}), d = gelu_pk((f32x2){v1[2], v1[3]});
                        v0 = (f32x4){a.x, a.y, b.x, b.y}; v1 = (f32x4){c.x, c.y, d.x, d.y}; }
                    if (ACT == 2) {
#pragma unroll
                        for (int j = 0; j < 4; ++j) { v0[j] = 0.5f * v0[j] * (1.0f + erff(v0[j] * 0.70710678f)); v1[j] = 0.5f * v1[j] * (1.0f + erff(v1[j] * 0.70710678f)); } }
                    u32x4 w; w.x = cvt_pk_bf16(v0[0], v0[1]); w.y = cvt_pk_bf16(v0[2], v0[3]); w.z = cvt_pk_bf16(v1[0], v1[1]); w.w = cvt_pk_bf16(v1[2], v1[3]);
                    *(u32x4*)(rowp + bj * HALF) = w; } }
    }
};
template <class Epi, class Sched, bool STAMP = false>
__device__ __forceinline__ void gemm_phase(PG8_LAS unsigned char* lds, const Gemm g, const Sched& S, const Epi& E, unsigned long long* stamps, const int tid_in) {
    int tid_ = tid_in; asm volatile("" : "+v"(tid_));
    const int tid = tid_, wid = __builtin_amdgcn_readfirstlane(tid >> 6), lane = tid & 63, wr = wid >> 2, wc = wid & 3, fr = lane & 15, fq = lane >> 4;
    const int K = g.K, nt = K / BK;
    int ts_lo = 0, ts_hi = 0, nts = 0; const unsigned long long rt_entry = STAMP ? (unsigned long long)wall_clock64() : 0ull;
#define PG8_STAMP() do { if (STAMP && wid == 0 && nts < 64) { const unsigned long long _c = (unsigned long long)clock64(); \
        ts_lo = (lane == nts) ? (int)(unsigned)_c : ts_lo; ts_hi = (lane == nts) ? (int)(unsigned)(_c >> 32) : ts_hi; ++nts; } } while (0)
    PG8_STAMP();
    unsigned voffA[2], voffB[2];
#pragma unroll
    for (int i = 0; i < 2; ++i) { int R, C; stage_rc(tid * 16 + i * 8192, R, C); const int Rb = Epi::PERM ? ((R & ~31) + perm32(R & 31)) : R;
        voffA[i] = (unsigned)(R * K + C) * 2u; voffB[i] = (unsigned)(Rb * K + C) * 2u; }
    const size_t kstep = (size_t)(BK * 2);
    const size_t hstep = (size_t)HALF * K * 2;
    const size_t tstep = 2 * hstep;
    const unsigned ldsw = (unsigned)wid * 1024u;
    const int aoff = lds_byte(wr * 64 + fr, fq * 8), boff = lds_byte(wc * 32 + fr, fq * 8);
#define PG8_SA(b, h) (((b) * 2 + (h)) * HTB)
#define PG8_SB(b, h) ((4 + (b) * 2 + (h)) * HTB)
#define PG8_STAGE(bufoff, gbase, voff) do { _Pragma("unroll") for (int _i = 0; _i < 2; ++_i) \
        __builtin_amdgcn_global_load_lds((const unsigned*)((const char*)(gbase) + (voff)[_i]), (PG8_LAS unsigned*)(lds + (bufoff) + ldsw + _i * 8192), 16, 0, 0); } while (0)
#define PG8_LDA(dst, b, h) do { _Pragma("unroll") for (int m = 0; m < 4; ++m) _Pragma("unroll") for (int k = 0; k < 2; ++k) dst[m][k] = *(const PG8_LAS bf16x8*)(lds + PG8_SA(b, h) + aoff + m * 2048 + k * 1024); } while (0)
#define PG8_LDB(dst, b, h) do { _Pragma("unroll") for (int n = 0; n < 2; ++n) _Pragma("unroll") for (int k = 0; k < 2; ++k) dst[n][k] = *(const PG8_LAS bf16x8*)(lds + PG8_SB(b, h) + boff + n * 2048 + k * 1024); } while (0)
#define PG8_MMA(ai, bj, At, Bt) do { __builtin_amdgcn_s_setprio(1); _Pragma("unroll") for (int m = 0; m < 4; ++m) _Pragma("unroll") for (int n = 0; n < 2; ++n) _Pragma("unroll") for (int k = 0; k < 2; ++k) \
        acc[ai][bj][m][n] = __builtin_amdgcn_mfma_f32_16x16x32_bf16(Bt[n][k], At[m][k], acc[ai][bj][m][n], 0, 0, 0); __builtin_amdgcn_s_setprio(0); } while (0)
#define PG8_WAIT_V(n) asm volatile("s_waitcnt vmcnt(" #n ")" ::: "memory")
#define PG8_WAIT_L(n) asm volatile("s_waitcnt lgkmcnt(" #n ")" ::: "memory")
#define PG8_BAR __builtin_amdgcn_s_barrier()
#define PG8_SCHED __builtin_amdgcn_sched_barrier(0)
    Unit cur, nxt; int ui = 0;
    if (!S.next(0, cur)) return;
    f32x4 acc[2][2][4][2];
#pragma unroll
    for (int a = 0; a < 2; ++a)
#pragma unroll
        for (int b = 0; b < 2; ++b)
#pragma unroll
            for (int m = 0; m < 4; ++m)
#pragma unroll
                for (int n = 0; n < 2; ++n) acc[a][b][m][n] = (f32x4){0.f, 0.f, 0.f, 0.f};
    bf16x8 At[4][2], B0[2][2], B1[2][2];
    const char* cA = (const char*)g.A + (size_t)cur.pm * tstep; const char* cB = (const char*)g.Bt + (size_t)cur.pn * tstep;
    S.a_ready(cur);
    PG8_STAGE(PG8_SB(0, 0), cB, voffB); PG8_STAGE(PG8_SA(0, 0), cA, voffA); PG8_STAGE(PG8_SB(0, 1), cB + hstep, voffB); PG8_STAGE(PG8_SA(0, 1), cA + hstep, voffA);
    if (wr == 1) PG8_BAR;
    PG8_WAIT_V(4); PG8_BAR;
    PG8_STAGE(PG8_SB(1, 0), cB + kstep, voffB); PG8_STAGE(PG8_SA(1, 0), cA + kstep, voffA); PG8_STAGE(PG8_SB(1, 1), cB + hstep + kstep, voffB);
    PG8_WAIT_V(6); PG8_BAR;
    PG8_STAMP();
    for (;;) {
        const bool has_next = S.next(ui + 1, nxt);
        const char* nA = has_next ? (const char*)g.A + (size_t)nxt.pm * tstep : cA; const char* nB = has_next ? (const char*)g.Bt + (size_t)nxt.pn * tstep : cB;
        for (int t = 0; t < nt; t += 2) {
            const bool last = (t == nt - 2);
            const char* a1 = cA + (size_t)(t + 1) * kstep;
            const char* a2 = last ? nA : cA + (size_t)(t + 2) * kstep; const char* b2 = last ? nB : cB + (size_t)(t + 2) * kstep;
            const char* a3 = a2 + kstep; const char* b3 = b2 + kstep;
            if (last && has_next) S.a_ready(nxt);
            PG8_LDB(B0, 0, 0); PG8_SCHED; PG8_LDA(At, 0, 0); PG8_STAGE(PG8_SA(1, 1), a1 + hstep, voffA);
            PG8_WAIT_L(8); PG8_BAR; PG8_WAIT_L(0); PG8_MMA(0, 0, At, B0); PG8_BAR; PG8_SCHED;
            PG8_LDB(B1, 0, 1); PG8_STAGE(PG8_SB(0, 0), b2, voffB);
            PG8_BAR; PG8_WAIT_L(0); PG8_MMA(0, 1, At, B1); PG8_BAR;
            PG8_LDA(At, 0, 1); PG8_STAGE(PG8_SA(0, 0), a2, voffA);
            PG8_BAR; PG8_WAIT_L(0); PG8_MMA(1, 0, At, B0); PG8_BAR; PG8_SCHED;
            PG8_STAGE(PG8_SB(0, 1), b2 + hstep, voffB);
            PG8_WAIT_V(6); PG8_BAR; PG8_MMA(1, 1, At, B1); PG8_BAR;
            PG8_LDB(B0, 1, 0); PG8_SCHED; PG8_LDA(At, 1, 0); PG8_STAGE(PG8_SA(0, 1), a2 + hstep, voffA);
            PG8_WAIT_L(8); PG8_BAR; PG8_WAIT_L(0); PG8_MMA(0, 0, At, B0); PG8_BAR; PG8_SCHED;
            PG8_LDB(B1, 1, 1); PG8_STAGE(PG8_SB(1, 0), b3, voffB);
            PG8_BAR; PG8_WAIT_L(0); PG8_MMA(0, 1, At, B1); PG8_BAR;
            PG8_LDA(At, 1, 1); PG8_STAGE(PG8_SA(1, 0), a3, voffA);
            PG8_BAR; PG8_WAIT_L(0); PG8_MMA(1, 0, At, B0); PG8_BAR; PG8_SCHED;
            PG8_STAGE(PG8_SB(1, 1), b3 + hstep, voffB);
            PG8_WAIT_V(6); PG8_BAR; PG8_MMA(1, 1, At, B1); PG8_BAR;
        }
        PG8_STAMP();
        if constexpr (!Epi::AFTER_DRAIN) { E(acc, cur, wr, wc, fr, fq); S.done(cur); }
        PG8_STAMP();
        if (!has_next) break;
#pragma unroll
        for (int a = 0; a < 2; ++a)
#pragma unroll
            for (int b = 0; b < 2; ++b)
#pragma unroll
                for (int m = 0; m < 4; ++m)
#pragma unroll
                    for (int n = 0; n < 2; ++n) acc[a][b][m][n] = (f32x4){0.f, 0.f, 0.f, 0.f};
        cur = nxt; cA = nA; cB = nB; ++ui;
    }
    PG8_WAIT_V(0);
    if (wr == 0) PG8_BAR;
    PG8_BAR;
    if constexpr (Epi::AFTER_DRAIN) { E.fused(acc, cur, wr, wc, fr, fq, lds, wid, lane); S.done(cur); }
    PG8_STAMP();
    if (STAMP && wid == 0) { stamps[lane] = lane < nts ? (((unsigned long long)(unsigned)ts_hi << 32) | (unsigned)ts_lo) : 0ull;
        if (lane == 62) stamps[62] = rt_entry; if (lane == 63) stamps[63] = (unsigned long long)wall_clock64(); }
#undef PG8_STAMP
#undef PG8_SA
#undef PG8_SB
#undef PG8_STAGE
#undef PG8_LDA
#undef PG8_LDB
#undef PG8_MMA
#undef PG8_WAIT_V
#undef PG8_WAIT_L
#undef PG8_BAR
#undef PG8_SCHED
}
}

namespace cg = cooperative_groups;
#define LAS __attribute__((address_space(3)))
typedef unsigned short bf16_t;
typedef short bf16x8 __attribute__((ext_vector_type(8)));
typedef float f32x4 __attribute__((ext_vector_type(4)));
typedef unsigned u32x4 __attribute__((ext_vector_type(4)));
typedef unsigned u32x2 __attribute__((ext_vector_type(2)));

constexpr int DM = 1024, NTOK = 12288, NCTX = 8192, DIN = 5632, DMIX = 1536;
constexpr int LDS_BYTES = 147456;
constexpr size_t MiB = 1u << 20;
constexpr size_t WS_CTL = 0;
constexpr size_t WS_MOD = 64 * 1024;
constexpr size_t WS_ROPE = 256 * 1024;
constexpr size_t WS_WIN = 1 * MiB;
constexpr size_t WS_WOUT = 23 * MiB;
constexpr size_t WS_PROJ = 29 * MiB;
constexpr size_t WS_OF = 161 * MiB;
constexpr size_t WS_XN = 197 * MiB;
constexpr size_t WS_OB = 213 * MiB;
constexpr size_t WS_END = 249 * MiB;

struct Params { const float* in[24]; float* out; unsigned char* ws; int kin, kout; };
#if defined(__HIP_DEVICE_COMPILE__)
#define GAS1 __attribute__((address_space(1)))
#else
#define GAS1
#endif
struct ParamsG { const GAS1 float* in[24]; GAS1 float* out; GAS1 unsigned char* ws; int kin, kout; };

struct Ctx {
    const float *x_prompt, *x_sample, *state_lru, *state_hgrn, *state_ret, *c, *c_ctx, *norm_g, *w_mod, *b_mod, *w_in, *conv_w, *conv_b,
        *lru_wa, *lru_ba, *lru_wx, *lru_bx, *lru_lambda, *hgrn_lb_logits, *hgrn_norm_g, *ret_decay_logit, *ret_norm_g, *w_out, *final_g;
    float* out; unsigned* ctl; float* MOD; float* ROPE; bf16_t *WIN, *WOUT, *PROJ, *OF, *OB, *XN;
};

__device__ __forceinline__ float bf2f(bf16_t b) { return __uint_as_float(((unsigned)b) << 16); }
typedef float cvt_f2 __attribute__((ext_vector_type(2)));
typedef __bf16 cvt_b2 __attribute__((ext_vector_type(2)));
__device__ __forceinline__ unsigned pk2(float lo, float hi) { const cvt_f2 v = {lo, hi}; const cvt_b2 r = __builtin_convertvector(v, cvt_b2); return __builtin_bit_cast(unsigned, r); }
__device__ __forceinline__ unsigned f2bf(float f) { return pk2(f, f) & 0xffffu; }
__device__ __forceinline__ float frcp(float x) { return __builtin_amdgcn_rcpf(x); }
__device__ __forceinline__ int launder_v(int v) { asm volatile("" : "+v"(v)); return v; }
__device__ __forceinline__ int tid_of(int wave_s) { int z = 0; asm volatile("" : "+v"(z));
    return launder_v(wave_s * 64 + (int)__builtin_amdgcn_mbcnt_hi(~0u, __builtin_amdgcn_mbcnt_lo(~0u, (unsigned)z))); }
__device__ __forceinline__ float wave_sum(float v) {
#pragma unroll
    for (int o = 1; o < 64; o <<= 1) v += __shfl_xor(v, o);
    return v;
}
__device__ __forceinline__ float silu_f(float x) { return x * frcp(1.f + __expf(-x)); }
__device__ __forceinline__ float sigm_f(float x) { return frcp(1.f + __expf(-x)); }

__device__ __forceinline__ void p0_transpose_item(const float* W, int K, int N, bf16_t* WT, LAS float* scr, int item, int lane) {
    const int nblk = N / 32, kb = item / nblk, nb = item % nblk, k0 = 64 * kb, n0 = 32 * nb;
    float tv[32];
#pragma unroll
    for (int i = 0; i < 32; ++i) { const int kk = 2 * i + (lane >> 5); tv[i] = W[(size_t)(k0 + kk) * N + n0 + (lane & 31)]; }
#pragma unroll
    for (int i = 0; i < 32; ++i) { const int kk = 2 * i + (lane >> 5); scr[kk * 33 + (lane & 31)] = tv[i]; }
    asm volatile("s_waitcnt lgkmcnt(0)" ::: "memory");
    const int c = lane & 7;
#pragma unroll
    for (int j = 0; j < 4; ++j) { const int n = (lane >> 3) + 8 * j; const LAS float* s = scr + (8 * c) * 33 + n;
        u32x4 o; o.x = pk2(s[0 * 33], s[1 * 33]); o.y = pk2(s[2 * 33], s[3 * 33]); o.z = pk2(s[4 * 33], s[5 * 33]); o.w = pk2(s[6 * 33], s[7 * 33]);
        *(u32x4*)(WT + (size_t)(n0 + n) * K + k0 + 8 * c) = o; }
    asm volatile("s_waitcnt lgkmcnt(0)" ::: "memory");
}

constexpr int CW_MODCNT = 256;
__device__ __forceinline__ void phase0(const Ctx& X, LAS unsigned char* sm, int tid) {
    const int lane = tid & 63, wave = tid >> 6;
    const bool split = gridDim.x > 96;
    LAS float* sc = (LAS float*)(sm + 69632);
    LAS float* red = (LAS float*)(sm + 90112);
    for (int unit = blockIdx.x; unit < 96; unit += gridDim.x) {
        const int l = unit / 48, jb = unit % 48;
        __syncthreads();
        for (int idx = tid; idx < 5 * 1024; idx += 512) { const int c = idx >> 10, k = idx & 1023; const float v = (c == 0) ? X.c_ctx[k] : X.c[(c - 1) * 1024 + k]; sc[idx] = silu_f(v); }
        __syncthreads();
        const int col = jb * 64 + lane; float a0 = 0.f, a1 = 0.f, a2 = 0.f, a3 = 0.f, a4 = 0.f;
        const float* wp = X.w_mod + ((size_t)l * 1024 + wave * 128) * 3072 + col;
#pragma unroll 16
        for (int kk = 0; kk < 128; ++kk) { const float wv = wp[(size_t)kk * 3072]; const int k = wave * 128 + kk;
            a0 += sc[k] * wv; a1 += sc[1024 + k] * wv; a2 += sc[2048 + k] * wv; a3 += sc[3072 + k] * wv; a4 += sc[4096 + k] * wv; }
        red[(wave * 5 + 0) * 64 + lane] = a0; red[(wave * 5 + 1) * 64 + lane] = a1; red[(wave * 5 + 2) * 64 + lane] = a2; red[(wave * 5 + 3) * 64 + lane] = a3; red[(wave * 5 + 4) * 64 + lane] = a4;
        __syncthreads();
        if (tid < 320) { const int c = tid >> 6, ln = tid & 63; float s = 0.f;
#pragma unroll
            for (int g = 0; g < 8; ++g) s += red[(g * 5 + c) * 64 + ln];
            X.MOD[(size_t)(l * 5 + c) * 3072 + jb * 64 + ln] = s + X.b_mod[l * 3072 + jb * 64 + ln]; }
        asm volatile("s_waitcnt vmcnt(0)" ::: "memory");
        __syncthreads();
        if (tid == 0) { __builtin_amdgcn_fence(__ATOMIC_RELEASE, "agent"); asm volatile("s_waitcnt vmcnt(0)" ::: "memory");
            __hip_atomic_fetch_add(X.ctl + CW_MODCNT, 1u, __ATOMIC_RELAXED, __HIP_MEMORY_SCOPE_AGENT); }
    }
    {
        const int first = split ? 96 : 0;
        if ((int)blockIdx.x >= first) {
            const int gw = ((int)blockIdx.x - first) * 8 + wave, NGW = ((int)gridDim.x - first) * 8;
            LAS float* scr = (LAS float*)(sm + wave * 8448);
            constexpr int I_IN = 16 * 176, I_OUT = 24 * 32, NIT = I_IN + I_OUT;
            for (int it = gw; it < NIT; it += NGW) {
                int r = it;
                if (r < I_IN) p0_transpose_item(X.w_in, 1024, 5632, X.WIN, scr, r, lane);
                else { r -= I_IN; p0_transpose_item(X.w_out, 1536, 1024, X.WOUT, scr, r, lane); }
            }
        }
    }
    if (blockIdx.x == gridDim.x - 1) {
        for (int idx = tid; idx < 2048; idx += 512) { const int pos = idx >> 5, fi = idx & 31;
            const float freq = exp2f(-(float)fi * (13.287712379549449f / 32.0f));
            const float ang = (float)pos * freq; const float rev = ang * 0.15915494309189535f; const float fr = rev - floorf(rev);
            X.ROPE[2 * idx] = __builtin_amdgcn_cosf(fr); X.ROPE[2 * idx + 1] = __builtin_amdgcn_sinf(fr); }
    }
    __syncthreads();
    if (tid == 0) { unsigned sp = 0;
        while (__hip_atomic_load(X.ctl + CW_MODCNT, __ATOMIC_RELAXED, __HIP_MEMORY_SCOPE_AGENT) < 96u) { __builtin_amdgcn_s_sleep(2); if (++sp > (1u << 22)) break; }
        __builtin_amdgcn_fence(__ATOMIC_ACQUIRE, "agent"); asm volatile("s_waitcnt vmcnt(0)" ::: "memory"); }
    __syncthreads();
}
__device__ __forceinline__ void l1_weights_idle(const Ctx& X, LAS unsigned char* sm, int tid, int idle_idx, int nidle) {
    const int lane = tid & 63, wave = tid >> 6;
    if (nidle <= 0 || idle_idx < 0) return;
    const int gw = idle_idx * 8 + wave, NGW = nidle * 8;
    LAS float* scr = (LAS float*)(sm + wave * 8448);
    constexpr int I_IN = 16 * 176, I_OUT = 24 * 32, NIT = I_IN + I_OUT;
    for (int it = gw; it < NIT; it += NGW) {
        int r = it;
        if (r < I_IN) p0_transpose_item(X.w_in + (size_t)1024 * 5632, 1024, 5632, X.WIN + (size_t)5632 * 1024, scr, r, lane);
        else { r -= I_IN; p0_transpose_item(X.w_out + (size_t)1536 * 1024, 1536, 1024, X.WOUT + (size_t)1024 * 1536, scr, r, lane); }
    }
}
__device__ __forceinline__ void phase_xn(const Ctx& X, int l, int tid, int xbase = -1) {
    const int lane = tid & 63, wave = tid >> 6;
    const int gw = blockIdx.x * 8 + wave, NGW = gridDim.x * 8;
    for (int k = 0;; ++k) {
        const int row = (xbase >= 0) ? xbase + wave * 6 + k : gw + k * NGW;
        if ((xbase >= 0) ? (k >= 6) : (row >= NTOK)) break;
        const float* xr = (l == 0) ? ((row < NCTX) ? X.x_prompt + (size_t)row * DM : X.x_sample + (size_t)(row - NCTX) * DM) : X.out + (size_t)row * DM;
        const int c = (row < NCTX) ? 0 : 1 + ((row - NCTX) >> 10);
        const float* md = X.MOD + (size_t)(l * 5 + c) * 3072;
        f32x4 v[4]; float s = 0.f;
#pragma unroll
        for (int j = 0; j < 4; ++j) { v[j] = ((const f32x4*)xr)[lane + 64 * j]; s += (v[j].x * v[j].x + v[j].y * v[j].y) + (v[j].z * v[j].z + v[j].w * v[j].w); }
        f32x4 pg[4], psh[4], pscl[4];
#pragma unroll
        for (int j = 0; j < 4; ++j) { const int k0 = (lane + 64 * j) * 4; pg[j] = *(const f32x4*)(X.norm_g + l * 1024 + k0); psh[j] = *(const f32x4*)(md + k0); pscl[j] = *(const f32x4*)(md + 1024 + k0); }
        const float r = rsqrtf(wave_sum(s) * (1.f / 1024.f) + 1e-6f);
#pragma unroll
        for (int j = 0; j < 4; ++j) { const int k0 = (lane + 64 * j) * 4;
            const f32x4 g = pg[j], sh = psh[j], scl = pscl[j];
            const f32x4 y = v[j] * r * g * (scl + 1.0f) + sh;
            u32x2 o; o.x = pk2(y.x, y.y); o.y = pk2(y.z, y.w);
            *(u32x2*)(X.XN + (size_t)row * DM + k0) = o; }
    }
}

__device__ __forceinline__ void unpack8(const u32x4 p, float (&f)[8]) {
    f[0] = __uint_as_float(p.x << 16); f[1] = __uint_as_float(p.x & 0xffff0000u); f[2] = __uint_as_float(p.y << 16); f[3] = __uint_as_float(p.y & 0xffff0000u);
    f[4] = __uint_as_float(p.z << 16); f[5] = __uint_as_float(p.z & 0xffff0000u); f[6] = __uint_as_float(p.w << 16); f[7] = __uint_as_float(p.w & 0xffff0000u);
}
__device__ __forceinline__ void phase_post(const Ctx& X, int l, int tid, int xbase = -1) {
    const int lane = tid & 63, wave = tid >> 6;
    const int gw = blockIdx.x * 8 + wave, NGW = gridDim.x * 8;
    for (int k = 0;; ++k) {
        const int row = (xbase >= 0) ? xbase + wave * 6 + k : gw + k * NGW;
        if ((xbase >= 0) ? (k >= 6) : (row >= NTOK)) break;
        bf16_t* of = X.OF + (size_t)row * DMIX; const bf16_t* ob = X.OB + (size_t)row * DMIX; const bf16_t* pr = X.PROJ + (size_t)row * DIN;
        const int ch0 = lane * 8;
        u32x4 la[3], lb2[3], lg[3];
#pragma unroll
        for (int pass = 0; pass < 3; ++pass) { const int gcol = (pass == 0) ? 512 : (pass == 1) ? 3072 : 5120;
            la[pass] = *(const u32x4*)(of + pass * 512 + ch0); lb2[pass] = *(const u32x4*)(ob + pass * 512 + ch0); lg[pass] = *(const u32x4*)(pr + gcol + ch0); }
#pragma unroll
        for (int pass = 0; pass < 3; ++pass) {
            float a[8], b[8], g[8], y[8];
            unpack8(la[pass], a); unpack8(lb2[pass], b); unpack8(lg[pass], g);
            float ss = 0.f;
#pragma unroll
            for (int j = 0; j < 8; ++j) { y[j] = a[j] + b[j]; ss += y[j] * y[j]; }
            if (pass > 0) {
                ss += __shfl_xor(ss, 1); ss += __shfl_xor(ss, 2); ss += __shfl_xor(ss, 4); ss += __shfl_xor(ss, 8);
                const float rn = rsqrtf(ss * (1.f / 128.f) + 1e-6f);
                const float* ng = ((pass == 1) ? X.hgrn_norm_g : X.ret_norm_g) + l * 512 + ch0;
                const f32x4 g0 = *(const f32x4*)ng, g1 = *(const f32x4*)(ng + 4);
                y[0] *= rn * g0.x; y[1] *= rn * g0.y; y[2] *= rn * g0.z; y[3] *= rn * g0.w; y[4] *= rn * g1.x; y[5] *= rn * g1.y; y[6] *= rn * g1.z; y[7] *= rn * g1.w;
            }
#pragma unroll
            for (int j = 0; j < 8; ++j) y[j] *= (pass == 2 && ch0 >= 256 && row < NCTX) ? silu_f(g[j]) : g[j];
            u32x4 o; o.x = pk2(y[0], y[1]); o.y = pk2(y[2], y[3]); o.z = pk2(y[4], y[5]); o.w = pk2(y[6], y[7]);
            *(u32x4*)(of + pass * 512 + ch0) = o;
        }
    }
}

__device__ __forceinline__ void phase_final(const Ctx& X, int tid, int xbase = -1) {
    const int lane = tid & 63, wave = tid >> 6;
    const int gw = blockIdx.x * 8 + wave, NGW = gridDim.x * 8;
    for (int k = 0;; ++k) {
        const int row = (xbase >= 0) ? xbase + wave * 6 + k : gw + k * NGW;
        if ((xbase >= 0) ? (k >= 6) : (row >= NTOK)) break;
        float* xr = X.out + (size_t)row * DM;
        f32x4 v[4]; float s = 0.f;
#pragma unroll
        for (int j = 0; j < 4; ++j) { v[j] = ((const f32x4*)xr)[lane + 64 * j]; s += (v[j].x * v[j].x + v[j].y * v[j].y) + (v[j].z * v[j].z + v[j].w * v[j].w); }
        f32x4 fg[4];
#pragma unroll
        for (int j = 0; j < 4; ++j) fg[j] = *(const f32x4*)(X.final_g + (lane + 64 * j) * 4);
        const float r = rsqrtf(wave_sum(s) * (1.f / 1024.f) + 1e-6f);
#pragma unroll
        for (int j = 0; j < 4; ++j) ((f32x4*)xr)[lane + 64 * j] = v[j] * r * fg[j];
    }
}

struct EpiResid {
    static constexpr bool PERM = false, AFTER_DRAIN = false;
    const float* xp; const float* xs; float* out; const float* modl; int layer;
    __device__ __forceinline__ void operator()(const pg8::f32x4 (&acc)[2][2][4][2], const pg8::Unit& u, int wr, int wc, int fr, int fq) const {
        const int row0 = u.pm * 256 + wr * 64 + fr, col0 = u.pn * 256 + wc * 32 + 4 * fq;
        const int c = (u.pm < 32) ? 0 : 1 + ((u.pm - 32) >> 2);
        const float* gate = modl + (size_t)c * 3072 + 2048 + col0;
        pg8::f32x4 gv[2][2];
#pragma unroll
        for (int bj = 0; bj < 2; ++bj)
#pragma unroll
            for (int n = 0; n < 2; ++n) gv[bj][n] = *(const pg8::f32x4*)(gate + bj * 128 + n * 16);
#pragma unroll
        for (int ai = 0; ai < 2; ++ai)
#pragma unroll
            for (int mp = 0; mp < 2; ++mp) {
                pg8::f32x4 xv[2][2][2];
#pragma unroll
                for (int mm = 0; mm < 2; ++mm) { const int row = row0 + ai * 128 + (mp * 2 + mm) * 16;
                    const float* xr = (layer == 0) ? ((row < NCTX) ? xp + (size_t)row * DM : xs + (size_t)(row - NCTX) * DM) : out + (size_t)row * DM;
#pragma unroll
                    for (int bj = 0; bj < 2; ++bj)
#pragma unroll
                        for (int n = 0; n < 2; ++n) xv[mm][bj][n] = *(const pg8::f32x4*)(xr + col0 + bj * 128 + n * 16); }
                asm volatile("" ::: "memory");
#pragma unroll
                for (int mm = 0; mm < 2; ++mm) { float* orow = out + (size_t)(row0 + ai * 128 + (mp * 2 + mm) * 16) * DM;
#pragma unroll
                    for (int bj = 0; bj < 2; ++bj)
#pragma unroll
                        for (int n = 0; n < 2; ++n) *(pg8::f32x4*)(orow + col0 + bj * 128 + n * 16) = xv[mm][bj][n] + gv[bj][n] * acc[ai][bj][mp * 2 + mm][n]; }
                asm volatile("" ::: "memory");
            }
    }
};

template <int FIXED_ACT> struct EpiProjT {
    static constexpr bool PERM = true, AFTER_DRAIN = false;
    bf16_t* O;
    __device__ __forceinline__ void operator()(const pg8::f32x4 (&acc)[2][2][4][2], const pg8::Unit& u, int wr, int wc, int fr, int fq) const {
        const int row0 = u.pm * 256 + wr * 64 + fr; const int col0 = u.pn * 256 + wc * 32 + 8 * fq;
        const int act = (FIXED_ACT >= 0) ? FIXED_ACT : (u.pn == 2 || u.pn == 3 || u.pn == 4 || u.pn == 5 || u.pn == 12 || u.pn == 13 || u.pn == 20 || u.pn == 21) ? 1 : (u.pn >= 6 && u.pn <= 9) ? 2 : 0;
#pragma unroll
        for (int ai = 0; ai < 2; ++ai)
#pragma unroll
            for (int m = 0; m < 4; ++m) { bf16_t* rowp = O + (size_t)(row0 + ai * 128 + m * 16) * DIN + col0;
#pragma unroll
                for (int bj = 0; bj < 2; ++bj) { pg8::f32x4 v0 = acc[ai][bj][m][0], v1 = acc[ai][bj][m][1];
                    if (act == 1) {
#pragma unroll
                        for (int j = 0; j < 4; ++j) { v0[j] = silu_f(v0[j]); v1[j] = silu_f(v1[j]); } }
                    else if (act == 2) {
#pragma unroll
                        for (int j = 0; j < 4; ++j) { v0[j] = __expf(-fmaxf(v0[j], -80.f)); v1[j] = __expf(-fmaxf(v1[j], -80.f)); } }
                    u32x4 w4; w4.x = pk2(v0[0], v0[1]); w4.y = pk2(v0[2], v0[3]); w4.z = pk2(v1[0], v1[1]); w4.w = pk2(v1[2], v1[3]);
                    *(u32x4*)(rowp + bj * 128) = w4; } }
    }
};

#define MFMA16(a, b, c) __builtin_amdgcn_mfma_f32_16x16x32_bf16((a), (b), (c), 0, 0, 0)
constexpr int G_QM = 0, G_QS = 17408, G_KM = 34816, G_KT = 52224, G_VT = 68608, G_ST = 84992, G_AT = 119808, G_GD = 129024, G_SEG = 129536;
constexpr int L_MISC = 140000;

__device__ __forceinline__ void unpack8v(const u32x4 p, float (&f)[8]) {
    f[0] = __uint_as_float(p.x << 16); f[1] = __uint_as_float(p.x & 0xffff0000u); f[2] = __uint_as_float(p.y << 16); f[3] = __uint_as_float(p.y & 0xffff0000u);
    f[4] = __uint_as_float(p.z << 16); f[5] = __uint_as_float(p.z & 0xffff0000u); f[6] = __uint_as_float(p.w << 16); f[7] = __uint_as_float(p.w & 0xffff0000u);
}
__device__ __forceinline__ u32x4 pack8v(const float (&f)[8]) { u32x4 o; o.x = pk2(f[0], f[1]); o.y = pk2(f[2], f[3]); o.z = pk2(f[4], f[5]); o.w = pk2(f[6], f[7]); return o; }

template <bool ISRET, bool ROPE> __device__ __forceinline__ void gla_item(const Ctx& X, const int l, const int isdec, const int seq, const int hgl, const int dir, LAS unsigned char* sm, const int tid, unsigned* ctr, unsigned& nxt) {
    const int lane = tid & 63, w = __builtin_amdgcn_readfirstlane(tid >> 6);
    const int c8 = lane & 15, g = lane >> 4, d0 = c8 * 8, i0 = (4 * w + g) * 2;
    const int L = isdec ? 1024 : 256, row0 = isdec ? NCTX + seq * 1024 : seq * 256, nch = L >> 6;
    constexpr bool isret = ISRET; const int h = hgl & 3;
    const unsigned qcol = (unsigned)((isret ? 3584 : 1024) + h * 128 + d0);
    const unsigned zcol = (unsigned)((isret ? 4096 : (dir ? 2048 : 1536)) + h * 128 + d0);
    const unsigned vcol = (unsigned)((isret ? 4608 : 2560) + h * 128 + d0);
    const int ocol = 512 + hgl * 128;
    bf16_t* OUT = dir ? X.OB : X.OF;
    float lbv[8]; float gam = 1.f;
#pragma unroll
    for (int c = 0; c < 8; ++c) lbv[c] = 0.f;
    if (!isret) { if (l == 1) {
#pragma unroll
            for (int c = 0; c < 8; ++c) { const float a0 = X.hgrn_lb_logits[(0 * 2 + dir) * 512 + h * 128 + d0 + c], a1 = X.hgrn_lb_logits[(1 * 2 + dir) * 512 + h * 128 + d0 + c]; lbv[c] = frcp(1.f + __expf(a0 - a1)); } } }
    else { gam = sigm_f(X.ret_decay_logit[(l * 2 + dir) * 4 + h]); }
    const float lg2 = log2f(gam), g32 = exp2f(32.0f * lg2);
    const int quad = lane >> 4, r16 = lane & 15;
    const int tr = w >> 1, cbk = w & 1, dtb = 2 * (w >> 1), etb = (w & 1) * 4;
    f32x4 S[2][4];
    if (isdec) {
        const float* st = (isret ? X.state_ret : X.state_hgrn) + (size_t)((((seq * 2 + l) * 2 + dir) * 4 + h) * 128) * 128;
#pragma unroll
        for (int a = 0; a < 2; ++a)
#pragma unroll
            for (int b = 0; b < 4; ++b)
#pragma unroll
                for (int j = 0; j < 4; ++j) S[a][b][j] = st[((dtb + a) * 16 + quad * 4 + j) * 128 + (etb + b) * 16 + r16];
    } else {
#pragma unroll
        for (int a = 0; a < 2; ++a)
#pragma unroll
            for (int b = 0; b < 4; ++b) S[a][b] = (f32x4){0.f, 0.f, 0.f, 0.f};
    }
#pragma unroll
    for (int a = 0; a < 2; ++a)
#pragma unroll
        for (int b = 0; b < 4; ++b) { u32x2 o; o.x = pk2(S[a][b][0], S[a][b][1]); o.y = pk2(S[a][b][2], S[a][b][3]);
            *(LAS u32x2*)(sm + G_ST + ((etb + b) * 16 + r16) * 272 + ((dtb + a) * 16 + quad * 4) * 2) = o; }
    u32x4 rq[2], rz[2], rv[2];
#define GLA_LOAD(ci) do { const int cb_ = dir ? (nch - 1 - (ci)) * 64 : (ci) * 64; \
        _Pragma("unroll") for (int tt = 0; tt < 2; ++tt) { const int t_ = dir ? cb_ + 63 - (i0 + tt) : cb_ + i0 + tt; const unsigned ro_ = (unsigned)(row0 + t_) * (unsigned)DIN; \
            rq[tt] = *(const u32x4*)(X.PROJ + ro_ + qcol); rz[tt] = *(const u32x4*)(X.PROJ + ro_ + zcol); rv[tt] = *(const u32x4*)(X.PROJ + ro_ + vcol); } } while (0)
    GLA_LOAD(0);
    for (int ci = 0; ci < nch; ++ci) {
        const int cb = dir ? (nch - 1 - ci) * 64 : ci * 64;
        if (ci == nch - 1 && tid == 0) nxt = atomicAdd(ctr, 1u);
        float qq[2][8], kk[2][8], cum[2][8];
        {
            float ff[2][8];
#pragma unroll
            for (int tt = 0; tt < 2; ++tt) {
                float qr[8], zr[8]; unpack8v(rq[tt], qr); unpack8v(rz[tt], zr);
                if (!isret) {
#pragma unroll
                    for (int c = 0; c < 8; ++c) { const float e = zr[c]; const float sg = frcp(1.f + e); const float oml = 1.f - lbv[c];
                        ff[tt][c] = fmaxf(lbv[c] + oml * sg, 1e-20f); kk[tt][c] = oml * (e * sg); qq[tt][c] = qr[c]; }
                } else {
                    if constexpr (ROPE) { const int t_ = dir ? cb + 63 - (i0 + tt) : cb + i0 + tt; const int pos = (c8 < 8) ? (t_ >> 6) : (t_ & 63);
                        const float* rp = X.ROPE + 2 * (pos * 32 + 8 * (c8 & 3));
                        const f32x4 cs0 = *(const f32x4*)(rp), cs1 = *(const f32x4*)(rp + 4), cs2 = *(const f32x4*)(rp + 8), cs3 = *(const f32x4*)(rp + 12);
                        const float cc[8] = {cs0.x, cs0.z, cs1.x, cs1.z, cs2.x, cs2.z, cs3.x, cs3.z}, ss[8] = {cs0.y, cs0.w, cs1.y, cs1.w, cs2.y, cs2.w, cs3.y, cs3.w};
                        const bool first = (c8 & 4) == 0;
#pragma unroll
                        for (int c = 0; c < 8; ++c) { const float qo = __shfl_xor(qr[c], 4), ko = __shfl_xor(zr[c], 4);
                            qr[c] = first ? qr[c] * cc[c] - qo * ss[c] : qo * ss[c] + qr[c] * cc[c];
                            zr[c] = first ? zr[c] * cc[c] - ko * ss[c] : ko * ss[c] + zr[c] * cc[c]; } }
                    const float pt = exp2f((float)(i0 + tt - 31) * lg2);
#pragma unroll
                    for (int c = 0; c < 8; ++c) { cum[tt][c] = pt; kk[tt][c] = zr[c]; qq[tt][c] = qr[c] * 0.08838834764831845f; }
                }
            }
            if (!isret) {
            float wt[8];
#pragma unroll
            for (int c = 0; c < 8; ++c) { const float tot = ff[0][c] * ff[1][c]; float inc = tot;
                float u = __shfl_up(inc, 16); if (g >= 1) inc *= u;
                u = __shfl_up(inc, 32); if (g >= 2) inc *= u;
                float exc = __shfl_up(inc, 16); if (g == 0) exc = 1.f;
                cum[0][c] = exc * ff[0][c]; cum[1][c] = inc; wt[c] = inc; }
            if (g == 3) { *(LAS f32x4*)(sm + G_SEG + (w * 128 + d0) * 4) = (f32x4){wt[0], wt[1], wt[2], wt[3]}; *(LAS f32x4*)(sm + G_SEG + (w * 128 + d0 + 4) * 4) = (f32x4){wt[4], wt[5], wt[6], wt[7]}; }
            }
        }
        __syncthreads();
        {
            float Eref[8], E47[8], Mq[8];
            if (isret) {
#pragma unroll
                for (int c = 0; c < 8; ++c) { Eref[c] = g32; E47[c] = g32; Mq[c] = 1.f; }
            } else {
#pragma unroll
                for (int c = 0; c < 8; ++c) { Eref[c] = 1.f; E47[c] = 1.f; Mq[c] = 1.f; }
#pragma unroll
                for (int k = 3; k >= 0; --k) { const f32x4 a = *(LAS f32x4*)(sm + G_SEG + (k * 128 + d0) * 4), b = *(LAS f32x4*)(sm + G_SEG + (k * 128 + d0 + 4) * 4);
                    Eref[0] *= a.x; Eref[1] *= a.y; Eref[2] *= a.z; Eref[3] *= a.w; Eref[4] *= b.x; Eref[5] *= b.y; Eref[6] *= b.z; Eref[7] *= b.w;
                    if (w == k) {
#pragma unroll
                        for (int c = 0; c < 8; ++c) Mq[c] = Eref[c]; } }
#pragma unroll
                for (int k = 4; k < 8; ++k) { const f32x4 a = *(LAS f32x4*)(sm + G_SEG + (k * 128 + d0) * 4), b = *(LAS f32x4*)(sm + G_SEG + (k * 128 + d0 + 4) * 4);
                    if (w == k) {
#pragma unroll
                        for (int c = 0; c < 8; ++c) Mq[c] = E47[c]; }
                    E47[0] *= a.x; E47[1] *= a.y; E47[2] *= a.z; E47[3] *= a.w; E47[4] *= b.x; E47[5] *= b.y; E47[6] *= b.z; E47[7] *= b.w; }
                if (w < 4) {
#pragma unroll
                    for (int c = 0; c < 8; ++c) Mq[c] = frcp(Mq[c]); }
            }
            if (w == 0 && g == 0) { *(LAS f32x4*)(sm + G_GD + d0 * 4) = (f32x4){Eref[0] * E47[0], Eref[1] * E47[1], Eref[2] * E47[2], Eref[3] * E47[3]};
                *(LAS f32x4*)(sm + G_GD + (d0 + 4) * 4) = (f32x4){Eref[4] * E47[4], Eref[5] * E47[5], Eref[6] * E47[6], Eref[7] * E47[7]}; }
            unsigned ktp[8], vtp[8]; float ks0[8];
#pragma unroll
            for (int tt = 0; tt < 2; ++tt) {
                float qm[8], qs[8], km[8];
#pragma unroll
                for (int c = 0; c < 8; ++c) { const float P = cum[tt][c] * Mq[c]; qm[c] = qq[tt][c] * P; qs[c] = qm[c] * Eref[c]; km[c] = kk[tt][c] * frcp(P);
                    const float ksv = km[c] * E47[c];
                    if (tt == 0) ks0[c] = ksv; else ktp[c] = pk2(ks0[c], ksv); }
                *(LAS u32x4*)(sm + G_QM + (i0 + tt) * 272 + d0 * 2) = pack8v(qm);
                *(LAS u32x4*)(sm + G_QS + (i0 + tt) * 272 + d0 * 2) = pack8v(qs);
                *(LAS u32x4*)(sm + G_KM + (i0 + tt) * 272 + d0 * 2) = pack8v(km);
            }
            {
                const unsigned a0 = rv[0].x, a1 = rv[0].y, a2 = rv[0].z, a3 = rv[0].w, b0 = rv[1].x, b1 = rv[1].y, b2 = rv[1].z, b3 = rv[1].w;
                vtp[0] = (a0 & 0xffffu) | (b0 << 16); vtp[1] = (a0 >> 16) | (b0 & 0xffff0000u); vtp[2] = (a1 & 0xffffu) | (b1 << 16); vtp[3] = (a1 >> 16) | (b1 & 0xffff0000u);
                vtp[4] = (a2 & 0xffffu) | (b2 << 16); vtp[5] = (a2 >> 16) | (b2 & 0xffff0000u); vtp[6] = (a3 & 0xffffu) | (b3 << 16); vtp[7] = (a3 >> 16) | (b3 & 0xffff0000u);
            }
            const int swz = ((w ^ (c8 & 7)) * 16) + 4 * g;
#pragma unroll
            for (int c = 0; c < 8; ++c) { *(LAS unsigned*)(sm + G_KT + (d0 + c) * 128 + swz) = ktp[c]; *(LAS unsigned*)(sm + G_VT + (d0 + c) * 128 + swz) = vtp[c]; }
        }
        if (ci + 1 < nch) GLA_LOAD(ci + 1);
        __syncthreads();
        f32x4 O[4];
        __builtin_amdgcn_s_setprio(1);
        {
            bf16x8 aq[4];
#pragma unroll
            for (int ks = 0; ks < 4; ++ks) aq[ks] = *(LAS bf16x8*)(sm + G_QM + (tr * 16 + r16) * 272 + (ks * 32 + quad * 8) * 2);
#pragma unroll
            for (int tt = 0; tt < 2; ++tt) { const int tc = cbk * 2 + tt; f32x4 acc = (f32x4){0.f, 0.f, 0.f, 0.f};
                if (tc <= tr) {
#pragma unroll
                    for (int ks = 0; ks < 4; ++ks) { const bf16x8 bfr = *(LAS bf16x8*)(sm + G_KM + (tc * 16 + r16) * 272 + (ks * 32 + quad * 8) * 2); acc = MFMA16(aq[ks], bfr, acc); } }
#pragma unroll
                for (int j = 0; j < 4; ++j) { const int row = tr * 16 + quad * 4 + j, col = tc * 16 + r16; const float v = (col <= row) ? acc[j] : 0.f;
                    *(LAS bf16_t*)(sm + G_AT + row * 144 + col * 2) = (bf16_t)f2bf(v); } }
#pragma unroll
            for (int ks = 0; ks < 4; ++ks) aq[ks] = *(LAS bf16x8*)(sm + G_QS + (tr * 16 + r16) * 272 + (ks * 32 + quad * 8) * 2);
#pragma unroll
            for (int b = 0; b < 4; ++b) { O[b] = (f32x4){0.f, 0.f, 0.f, 0.f};
#pragma unroll
                for (int ks = 0; ks < 4; ++ks) { const bf16x8 afr = *(LAS bf16x8*)(sm + G_ST + ((etb + b) * 16 + r16) * 272 + (ks * 32 + quad * 8) * 2); O[b] = MFMA16(afr, aq[ks], O[b]); } }
        }
        __builtin_amdgcn_s_setprio(0);
        __syncthreads();
        {
            const int nks = (tr >= 2) ? 2 : 1;
            for (int ks = 0; ks < nks; ++ks) { const bf16x8 bt = *(LAS bf16x8*)(sm + G_AT + (tr * 16 + r16) * 144 + (ks * 32 + quad * 8) * 2);
#pragma unroll
                for (int b = 0; b < 4; ++b) { const int R = (etb + b) * 16 + r16; const bf16x8 afr = *(LAS bf16x8*)(sm + G_VT + R * 128 + ((((ks * 4 + quad) ^ (R >> 3)) & 7) * 16)); O[b] = MFMA16(afr, bt, O[b]); } }
            {
                const int i_ = tr * 16 + r16; const int t_ = dir ? cb + 63 - i_ : cb + i_;
                bf16_t* op = OUT + (size_t)(row0 + t_) * DMIX + ocol + etb * 16 + quad * 4;
#pragma unroll
                for (int b = 0; b < 4; ++b) { u32x2 o; o.x = pk2(O[b][0], O[b][1]); o.y = pk2(O[b][2], O[b][3]); *(u32x2*)(op + b * 16) = o; }
            }
#pragma unroll
            for (int a = 0; a < 2; ++a) { const f32x4 g4 = *(LAS f32x4*)(sm + G_GD + ((dtb + a) * 16 + quad * 4) * 4);
#pragma unroll
                for (int b = 0; b < 4; ++b) S[a][b] = S[a][b] * g4; }
#pragma unroll
            for (int ks = 0; ks < 2; ++ks) {
                bf16x8 bfr[4];
#pragma unroll
                for (int b = 0; b < 4; ++b) { const int R = (etb + b) * 16 + r16; bfr[b] = *(LAS bf16x8*)(sm + G_VT + R * 128 + ((((ks * 4 + quad) ^ (R >> 3)) & 7) * 16)); }
#pragma unroll
                for (int a = 0; a < 2; ++a) { const int R = (dtb + a) * 16 + r16; const bf16x8 af = *(LAS bf16x8*)(sm + G_KT + R * 128 + ((((ks * 4 + quad) ^ (R >> 3)) & 7) * 16));
#pragma unroll
                    for (int b = 0; b < 4; ++b) S[a][b] = MFMA16(af, bfr[b], S[a][b]); } }
#pragma unroll
            for (int a = 0; a < 2; ++a)
#pragma unroll
                for (int b = 0; b < 4; ++b) { u32x2 o; o.x = pk2(S[a][b][0], S[a][b][1]); o.y = pk2(S[a][b][2], S[a][b][3]);
                    *(LAS u32x2*)(sm + G_ST + ((etb + b) * 16 + r16) * 272 + ((dtb + a) * 16 + quad * 4) * 2) = o; }
        }
    }
#undef GLA_LOAD
    if (!isdec) {
        float* fo = X.out + (isret ? 21037056 : 12648448) + (size_t)((((seq * 2 + l) * 2 + dir) * 4 + h) * 128) * 128;
#pragma unroll
        for (int a = 0; a < 2; ++a)
#pragma unroll
            for (int b = 0; b < 4; ++b)
#pragma unroll
                for (int j = 0; j < 4; ++j) fo[((dtb + a) * 16 + quad * 4 + j) * 128 + (etb + b) * 16 + r16] = S[a][b][j];
    }
}

constexpr int R_U = 0, R_WT = 18432, R_GT = 36864, R_SA = 104448, R_SB = 108544, R_HC = 112640;
__device__ __forceinline__ void lru_item(const Ctx& X, const int l, const int isdec, const int seq, const int hb, const int dir, LAS unsigned char* sm, const int tid, unsigned* ctr, unsigned& nxt) {
    const int lane = tid & 63, w = __builtin_amdgcn_readfirstlane(tid >> 6);
    const int ch = lane, tq = w;
    const int L = isdec ? 1024 : 256, row0 = isdec ? NCTX + seq * 1024 : seq * 256, nch = L >> 7;
    const int gch = hb * 64 + ch;
    bf16_t* OUT = dir ? X.OB : X.OF;
    {
        const float* wa = X.lru_wa + (size_t)(((l * 2 + dir) * 8 + hb) * 64) * 64; const float* wx = X.lru_wx + (size_t)(((l * 2 + dir) * 8 + hb) * 64) * 64;
        float wv[16];
#pragma unroll
        for (int q = 0; q < 16; ++q) { const int idx = tid + 512 * q; const int which = idx >> 12, k = (idx >> 6) & 63, n = idx & 63; wv[q] = (which ? wx : wa)[k * 64 + n]; }
#pragma unroll
        for (int q = 0; q < 16; ++q) { const int idx = tid + 512 * q; const int which = idx >> 12, k = (idx >> 6) & 63, n = idx & 63;
            *(LAS bf16_t*)(sm + R_WT + (which * 64 + n) * 144 + k * 2) = (bf16_t)f2bf(wv[q]); }
    }
    const float w0 = X.conv_w[(l * 4 + 0) * 512 + gch], w1 = X.conv_w[(l * 4 + 1) * 512 + gch], w2 = X.conv_w[(l * 4 + 2) * 512 + gch], w3 = X.conv_w[(l * 4 + 3) * 512 + gch];
    const float cbias = X.conv_b[l * 512 + gch];
    const float wq0 = dir ? w3 : 0.f, wq1 = dir ? w2 : w0, wq2 = w1, wq3 = dir ? w0 : w2, wq4 = dir ? 0.f : w3;
    const float ba = X.lru_ba[(l * 2 + dir) * 512 + gch], bx = X.lru_bx[(l * 2 + dir) * 512 + gch];
    const float lam = X.lru_lambda[(l * 2 + dir) * 512 + gch];
    const float sp = (lam > 15.f) ? __expf(-lam) : log1pf(__expf(-lam));
    if (tq == 0) *(LAS float*)(sm + R_HC + ch * 4) = isdec ? X.state_lru[((seq * 2 + l) * 2 + dir) * 512 + gch] : 0.f;
    const int quad = lane >> 4, r16 = lane & 15;
    const int sgn = dir ? -1 : 1;
    bf16_t ext[20];
#define LRU_LOAD(ci) do { const int cb_ = dir ? (nch - 1 - (ci)) * 128 : (ci) * 128; const int tb_ = dir ? cb_ + 127 - tq * 16 : cb_ + tq * 16; \
        _Pragma("unroll") for (int q = 0; q < 20; ++q) { const int t_ = tb_ + sgn * (q - 2); ext[q] = (t_ >= 0 && t_ < L) ? X.PROJ[(size_t)(row0 + t_) * DIN + gch] : (bf16_t)0; } } while (0)
    LRU_LOAD(0);
    __syncthreads();
    float hfin = 0.f;
    for (int ci = 0; ci < nch; ++ci) {
        if (ci == nch - 1 && tid == 0) nxt = atomicAdd(ctr, 1u);
        const int cb = dir ? (nch - 1 - ci) * 128 : ci * 128; const int tb = dir ? cb + 127 - tq * 16 : cb + tq * 16;
        const int par = ci & 1;
        float uu[16];
        { float xe[20];
#pragma unroll
          for (int q = 0; q < 20; ++q) xe[q] = bf2f(ext[q]);
          if (ci + 1 < nch) LRU_LOAD(ci + 1);
#pragma unroll
          for (int j = 0; j < 16; ++j) { uu[j] = cbias + wq0 * xe[j] + wq1 * xe[j + 1] + wq2 * xe[j + 2] + wq3 * xe[j + 3] + wq4 * xe[j + 4];
              *(LAS bf16_t*)(sm + R_U + (tq * 16 + j) * 144 + ch * 2) = (bf16_t)f2bf(uu[j]); } }
        {
            f32x4 acc[8];
#pragma unroll
            for (int b = 0; b < 8; ++b) acc[b] = (f32x4){0.f, 0.f, 0.f, 0.f};
#pragma unroll
            for (int ks = 0; ks < 2; ++ks) { const bf16x8 af = *(LAS bf16x8*)(sm + R_U + (tq * 16 + r16) * 144 + (ks * 32 + quad * 8) * 2);
#pragma unroll
                for (int b = 0; b < 8; ++b) { const bf16x8 bfr = *(LAS bf16x8*)(sm + R_WT + (b * 16 + r16) * 144 + (ks * 32 + quad * 8) * 2); acc[b] = MFMA16(af, bfr, acc[b]); } }
#pragma unroll
            for (int b = 0; b < 8; ++b)
#pragma unroll
                for (int j = 0; j < 4; ++j) *(LAS float*)(sm + R_GT + ((tq * 16 + quad * 4 + j) * 132 + b * 16 + r16) * 4) = acc[b][j];
        }
        float aa[16], bb[16]; float Al = 1.f, Bl = 0.f;
#pragma unroll
        for (int j = 0; j < 16; ++j) { const int i_ = tq * 16 + j;
            const float prr = *(LAS float*)(sm + R_GT + (i_ * 132 + ch) * 4) + ba, pri = *(LAS float*)(sm + R_GT + (i_ * 132 + 64 + ch) * 4) + bx;
            const float rg = sigm_f(prr), ig = sigm_f(pri);
            const float la = -8.0f * rg * sp; const float a = __expf(la);
            const float om = fmaf(-a, a, 1.0f);
            const float b = __builtin_amdgcn_sqrtf(om) * (ig * uu[j]);
            aa[j] = a; bb[j] = b; Al *= a; Bl = a * Bl + b; }
        *(LAS float*)(sm + R_SA + ((par * 8 + tq) * 64 + ch) * 4) = Al; *(LAS float*)(sm + R_SB + ((par * 8 + tq) * 64 + ch) * 4) = Bl;
        __syncthreads();
        float hh = *(LAS float*)(sm + R_HC + (par * 64 + ch) * 4);
        { float sa[7], sb[7];
#pragma unroll
          for (int s = 0; s < 7; ++s) { sa[s] = *(LAS float*)(sm + R_SA + ((par * 8 + s) * 64 + ch) * 4); sb[s] = *(LAS float*)(sm + R_SB + ((par * 8 + s) * 64 + ch) * 4); }
#pragma unroll
          for (int s = 0; s < 7; ++s) if (s < tq) hh = sa[s] * hh + sb[s]; }
#pragma unroll
        for (int j = 0; j < 16; ++j) { hh = aa[j] * hh + bb[j]; const int t_ = tb + sgn * j; OUT[(size_t)(row0 + t_) * DMIX + gch] = (bf16_t)f2bf(hh); }
        hfin = hh;
        if (tq == 7) *(LAS float*)(sm + R_HC + ((par ^ 1) * 64 + ch) * 4) = hh;
    }
#undef LRU_LOAD
    if (!isdec && tq == 7) X.out[12582912 + ((seq * 2 + l) * 2 + dir) * 512 + gch] = hfin;
}


struct InProjOrder : pg8::StaticOrder {
    __device__ bool next(int i, pg8::Unit& u) const {
        const long Lq = (long)i * G + c;
        if (Lq < 1008) return pg8::StaticOrder::next(i, u);
        if (Lq < 1024) { u.pm = 32 + (int)(Lq - 1008); u.pn = 21; return true; }
        return false;
    }
};
struct OneUnit {
    int pm, pn;
    __device__ bool next(int i, pg8::Unit& u) const { if (i > 0) return false; u.pm = pm; u.pn = pn; return true; }
    __device__ __forceinline__ void a_ready(const pg8::Unit&) const {}
    __device__ __forceinline__ void done(const pg8::Unit&) const {}
};
__device__ __forceinline__ void phase_mixer(const Ctx& X, const int l, LAS unsigned char* sm, const int tid, const int kin) {
    unsigned* ctr = X.ctl + 64 * l;
    __syncthreads();
    if (tid == 0) *(LAS unsigned*)(sm + L_MISC) = atomicAdd(ctr, 1u);
    __syncthreads();
    int it = (int)__builtin_amdgcn_readfirstlane(*(LAS unsigned*)(sm + L_MISC));
    while (it < 1184) {
        unsigned nxt = 0u;
        __syncthreads();
        if (it < 32) {
            if (tid == 0) nxt = atomicAdd(ctr, 1u);
            pg8::Gemm g{X.XN, X.WIN + (size_t)l * DIN * DM, NTOK, DIN, kin}; OneUnit S{it, 21};
            pg8::EpiBf16<0> E{X.PROJ, DIN, nullptr, 0, 0};
            pg8::gemm_phase<pg8::EpiBf16<0>, OneUnit, false>(sm, g, S, E, nullptr, launder_v(tid));
        } else {
            const int it2 = it - 32;
            const int isdec = (it2 < 128) ? 1 : 0; const int k = isdec ? it2 : it2 - 128; const int per = isdec ? 64 : 512;
            const int kind = (k >= per) ? 1 : 0; const int kk = kind ? k - per : k;
            const int tid2 = launder_v(tid);
            if (kind == 0) { const int hgl_ = (kk >> 1) & 7;
                if (hgl_ < 4) gla_item<false, false>(X, l, isdec, kk >> 4, hgl_, kk & 1, sm, tid2, ctr, nxt);
                else if (isdec) gla_item<true, true>(X, l, 1, kk >> 4, hgl_, kk & 1, sm, tid2, ctr, nxt);
                else gla_item<true, false>(X, l, 0, kk >> 4, hgl_, kk & 1, sm, tid2, ctr, nxt); }
            else lru_item(X, l, isdec, kk >> 4, (kk >> 1) & 7, kk & 1, sm, tid2, ctr, nxt);
        }
        if (tid == 0) *(LAS unsigned*)(sm + L_MISC) = nxt;
        __syncthreads();
        it = (int)__builtin_amdgcn_readfirstlane(*(LAS unsigned*)(sm + L_MISC));
    }
}

#define XB_TMO      128
#define XB_XCNT(j)  (256  + 64 * (j))
#define XB_XSUB(j)  (1280 + 64 * (j))
#define XB_XGEN(j)  (2304 + 64 * (j))
#define XB_TOP      3328
#define XB_TOPGEN   3392
#define XCD_BAR_WORDS 3456
#define XB_SPIN_CAP (1u << 18)

__device__ __forceinline__ unsigned xb_ld(unsigned* p)              { return __hip_atomic_load(p, __ATOMIC_RELAXED, __HIP_MEMORY_SCOPE_AGENT); }
__device__ __forceinline__ unsigned xb_add(unsigned* p, unsigned v) { return __hip_atomic_fetch_add(p, v, __ATOMIC_RELAXED, __HIP_MEMORY_SCOPE_AGENT); }
__device__ __forceinline__ unsigned xb_xcc_id() { return (unsigned)__builtin_amdgcn_s_getreg((3 << 11) | 20) & 0xFu; }
#define XB_SPIN(cond, bar) do { unsigned _sp = 0; while (cond) { __builtin_amdgcn_s_sleep(1); \
    if ((++_sp & 255u) == 0u) { if (xb_ld(&(bar)[XB_TMO])) break; if (_sp > XB_SPIN_CAP) { atomicAdd(&(bar)[XB_TMO], 1u); break; } } } } while (0)

struct XcdBarrier {
    unsigned* bar; unsigned x;
    volatile LAS unsigned* st;
};

__device__ __forceinline__ XcdBarrier xcd_barrier_post(unsigned* bar, volatile LAS unsigned* st) {
    XcdBarrier b; b.bar = bar; b.x = xb_xcc_id(); b.st = st;
    if (threadIdx.x == 0) (void)xb_add(&bar[XB_XCNT(b.x)], 1u);
    return b;
}
__device__ __forceinline__ void xcd_barrier_complete(unsigned* bar, unsigned x, unsigned& nloc, unsigned& nx) {
    const unsigned G = gridDim.x * gridDim.y * gridDim.z;
    unsigned sum, cnt, mine, sp = 0u;
    for (;;) {
        sum = 0u; cnt = 0u; mine = 0u;
#pragma unroll
        for (unsigned j = 0; j < 16; ++j) { const unsigned c = xb_ld(&bar[XB_XCNT(j)]); sum += c; cnt += (c > 0u) ? 1u : 0u; mine = (j == x) ? c : mine; }
        if (sum == G) break;
        __builtin_amdgcn_s_sleep(1);
        if ((++sp & 255u) == 0u) { if (xb_ld(&bar[XB_TMO])) break; if (sp > XB_SPIN_CAP) { atomicAdd(&bar[XB_TMO], 1u); break; } }
    }
    nloc = mine > 0u ? mine : 1u; nx = cnt > 0u ? cnt : 1u;
}

__device__ __forceinline__ void xcd_barrier(const XcdBarrier& b) {
    asm volatile("s_waitcnt vmcnt(0)" ::: "memory");
    __syncthreads();
    if (threadIdx.x == 0) {
        unsigned* bar = b.bar;
        __builtin_amdgcn_s_waitcnt(0);
        unsigned nloc = b.st[0], nx = b.st[1];
        if (nloc == 0u) { xcd_barrier_complete(bar, b.x, nloc, nx); b.st[0] = nloc; b.st[1] = nx; }
        const unsigned old = xb_add(&bar[XB_XSUB(b.x)], 1u);
        const unsigned gen = old / nloc;
        if (old + 1u == (gen + 1u) * nloc) {
            __builtin_amdgcn_fence(__ATOMIC_RELEASE, "agent");
            asm volatile("s_waitcnt vmcnt(0)" ::: "memory");
            const unsigned og = xb_add(&bar[XB_TOP], 1u);
            const unsigned tg = og / nx;
            if (og + 1u == (tg + 1u) * nx) xb_add(&bar[XB_TOPGEN], 1u);
            else XB_SPIN(xb_ld(&bar[XB_TOPGEN]) == tg, bar);
            __builtin_amdgcn_fence(__ATOMIC_ACQUIRE, "agent");
            xb_add(&bar[XB_XGEN(b.x)], 1u);
            asm volatile("s_waitcnt vmcnt(0)" ::: "memory");
        } else {
            XB_SPIN(xb_ld(&bar[XB_XGEN(b.x)]) == gen, bar);
            __builtin_amdgcn_fence(__ATOMIC_ACQUIRE, "agent");
            asm volatile("s_waitcnt vmcnt(0)" ::: "memory");
        }
    }
    __syncthreads();
}

template <class T> __device__ __forceinline__ T* as_global(T* q) {
#if defined(__HIP_DEVICE_COMPILE__)
    return (T*)(__attribute__((address_space(1))) T*)q;
#else
    return q;
#endif
}
__device__ __forceinline__ const void* kernarg_ptr() {
#if defined(__HIP_DEVICE_COMPILE__)
    return (const void*)__builtin_amdgcn_kernarg_segment_ptr();
#else
    return nullptr;
#endif
}
__device__ __forceinline__ int kernarg_int(int off) {
#if defined(__HIP_DEVICE_COMPILE__)
    return *(const __attribute__((address_space(4))) int*)((const __attribute__((address_space(4))) char*)__builtin_amdgcn_kernarg_segment_ptr() + off);
#else
    return 0;
#endif
}
__device__ __forceinline__ Ctx make_ctx() {
#if defined(__HIP_DEVICE_COMPILE__)
    const __attribute__((address_space(4))) ParamsG* kp_ = (const __attribute__((address_space(4))) ParamsG*)__builtin_amdgcn_kernarg_segment_ptr(); asm volatile("" : "+s"(kp_));
    const __attribute__((address_space(4))) ParamsG& p = *kp_;
#else
    const ParamsG pp_{}; const ParamsG& p = pp_;
#endif
    Ctx X;
    X.x_prompt = (const float*)p.in[0]; X.x_sample = (const float*)p.in[1]; X.state_lru = (const float*)p.in[2]; X.state_hgrn = (const float*)p.in[3]; X.state_ret = (const float*)p.in[4]; X.c = (const float*)p.in[5]; X.c_ctx = (const float*)p.in[6]; X.norm_g = (const float*)p.in[7];
    X.w_mod = (const float*)p.in[8]; X.b_mod = (const float*)p.in[9]; X.w_in = (const float*)p.in[10]; X.conv_w = (const float*)p.in[11]; X.conv_b = (const float*)p.in[12]; X.lru_wa = (const float*)p.in[13]; X.lru_ba = (const float*)p.in[14]; X.lru_wx = (const float*)p.in[15];
    X.lru_bx = (const float*)p.in[16]; X.lru_lambda = (const float*)p.in[17]; X.hgrn_lb_logits = (const float*)p.in[18]; X.hgrn_norm_g = (const float*)p.in[19]; X.ret_decay_logit = (const float*)p.in[20]; X.ret_norm_g = (const float*)p.in[21];
    X.w_out = (const float*)p.in[22]; X.final_g = (const float*)p.in[23]; X.out = (float*)p.out; unsigned char* ws_ = (unsigned char*)p.ws;
    X.ctl = (unsigned*)(ws_ + WS_CTL); X.MOD = (float*)(ws_ + WS_MOD); X.ROPE = (float*)(ws_ + WS_ROPE);
    X.WIN = (bf16_t*)(ws_ + WS_WIN); X.WOUT = (bf16_t*)(ws_ + WS_WOUT); X.PROJ = (bf16_t*)(ws_ + WS_PROJ); X.OF = (bf16_t*)(ws_ + WS_OF); X.OB = (bf16_t*)(ws_ + WS_OB); X.XN = (bf16_t*)(ws_ + WS_XN);

    return X;
}

constexpr int CW_BAR = 1024;
constexpr int L_BARST = 140016;
__device__ __forceinline__ void mk_barrier(LAS unsigned char* sm) {
    const Ctx X = make_ctx();
    XcdBarrier b; b.bar = X.ctl + CW_BAR; b.x = xb_xcc_id(); b.st = (volatile LAS unsigned*)(sm + L_BARST);
    xcd_barrier(b);
}

constexpr int CW_XLOC = 4608;
constexpr int CW_XLB = 5632;
constexpr int CW_POSTDONE = 6720;
constexpr int L_XID = L_BARST + 16;
__device__ __forceinline__ void xl_barrier(unsigned* ctl, LAS unsigned char* sm, const int tid, const unsigned* extra = nullptr, const unsigned extra_target = 0u) {
    asm volatile("s_waitcnt vmcnt(0)" ::: "memory");
    __syncthreads();
    if (tid == 0) {
        unsigned* c = ctl + CW_XLB + 64 * *(LAS unsigned*)(sm + L_XID);
        const unsigned old = __hip_atomic_fetch_add(c, 1u, __ATOMIC_RELAXED, __HIP_MEMORY_SCOPE_AGENT);
        const unsigned target = (old / 32u + 1u) * 32u; unsigned sp = 0;
        for (;;) {
            const unsigned e = extra ? __hip_atomic_load(extra, __ATOMIC_RELAXED, __HIP_MEMORY_SCOPE_AGENT) : extra_target;
            const unsigned v = __hip_atomic_load(c, __ATOMIC_RELAXED, __HIP_MEMORY_SCOPE_AGENT);
            if ((v >= target && e >= extra_target) || ++sp > (1u << 22)) break;
            __builtin_amdgcn_s_sleep(1); }
        __builtin_amdgcn_fence(__ATOMIC_ACQUIRE, "agent"); asm volatile("s_waitcnt vmcnt(0)" ::: "memory");
    }
    __syncthreads();
}
struct OutOrder {
    pg8::StaticOrder so; int fast, pm, pn, has;
    __device__ bool next(int i, pg8::Unit& u) const { if (!fast) return so.next(i, u); if (i > 0 || !has) return false; u.pm = pm; u.pn = pn; return true; }
    __device__ __forceinline__ void a_ready(const pg8::Unit&) const {}
    __device__ __forceinline__ void done(const pg8::Unit&) const {}
};
template <int l> __device__ __forceinline__ void layer_phases(cg::grid_group& grid, LAS unsigned char* sm, const int wave_s) {
#define XCC_ID ((int)__builtin_amdgcn_readfirstlane(*(LAS unsigned*)(sm + L_XID)))
#define XCC_LI ((int)__builtin_amdgcn_readfirstlane(*(LAS unsigned*)(sm + L_XID + 4)))
#define XFAST (__builtin_amdgcn_readfirstlane(*(LAS unsigned*)(sm + L_XID + 8)) != 0u)
#define XBASE (XFAST ? XCC_ID * 1536 + XCC_LI * 48 : -1)
        if constexpr (l != 0) {
            if (!XFAST) {
                { const Ctx X = make_ctx(); phase_xn(X, l, tid_of(wave_s)); }
                mk_barrier(sm);
            }
        }
        {
            const Ctx X = make_ctx(); const int kin = kernarg_int(208);
            pg8::Gemm g{X.XN, X.WIN + (size_t)l * DIN * DM, NTOK, DIN, kin}; InProjOrder S; S.init(NTOK, DIN - 256, (int)gridDim.x, (int)blockIdx.x);
            EpiProjT<-1> E{X.PROJ};
            pg8::gemm_phase<EpiProjT<-1>, InProjOrder, false>(sm, g, S, E, nullptr, tid_of(wave_s));
        }
        mk_barrier(sm);
        { const Ctx X = make_ctx(); phase_mixer(X, l, sm, tid_of(wave_s), kernarg_int(208)); }
        mk_barrier(sm);
        { const Ctx X = make_ctx(); phase_post(X, l, tid_of(wave_s), XBASE); }
        if (XFAST) { const Ctx X = make_ctx(); xl_barrier(X.ctl, sm, tid_of(wave_s));
            if constexpr (l == 0) { if (tid_of(wave_s) == 0) __hip_atomic_fetch_add(X.ctl + CW_POSTDONE, 1u, __ATOMIC_RELAXED, __HIP_MEMORY_SCOPE_AGENT); }
        } else mk_barrier(sm);
        {
            const Ctx X = make_ctx(); const int kout = kernarg_int(212);
            pg8::Gemm g{X.OF, X.WOUT + (size_t)l * DM * DMIX, NTOK, DM, kout};
            OutOrder S; S.so.init(NTOK, DM, (int)gridDim.x, (int)blockIdx.x); { const int xli = XCC_LI; S.fast = XFAST ? 1 : 0; S.has = (S.fast && xli < 24) ? 1 : 0; S.pm = XCC_ID * 6 + (xli >> 2); S.pn = xli & 3; }
            EpiResid E{X.x_prompt, X.x_sample, X.out, X.MOD + (size_t)l * 5 * 3072, l};
            pg8::gemm_phase<EpiResid, OutOrder, false>(sm, g, S, E, nullptr, tid_of(wave_s));
            if constexpr (l == 0) {
                if (XFAST) { const int xli = XCC_LI; l1_weights_idle(X, sm, tid_of(wave_s), (xli >= 24) ? XCC_ID * 8 + (xli - 24) : -1, 64); }
                else if (gridDim.x > 192) l1_weights_idle(X, sm, tid_of(wave_s), (int)blockIdx.x - 192, (int)gridDim.x - 192);
                else l1_weights_idle(X, sm, tid_of(wave_s), (int)blockIdx.x, (int)gridDim.x);
            }
        }
        if (XFAST) {
            { const Ctx X = make_ctx(); if constexpr (l == 0) xl_barrier(X.ctl, sm, tid_of(wave_s), X.ctl + CW_POSTDONE, gridDim.x); else xl_barrier(X.ctl, sm, tid_of(wave_s)); }
            if constexpr (l == 0) {
                { const Ctx X = make_ctx(); phase_xn(X, 1, tid_of(wave_s), XBASE); } mk_barrier(sm); }
            else { const Ctx X = make_ctx(); phase_final(X, tid_of(wave_s), XBASE); }
        } else mk_barrier(sm);
    }
#undef XCC_ID
#undef XCC_LI
#undef XFAST
#undef XBASE
__global__ void __launch_bounds__(512, 2) fwd_megakernel(Params p) {
    extern __shared__ __attribute__((aligned(16))) unsigned char lds[];
    cg::grid_group grid = cg::this_grid();
    LAS unsigned char* sm = (LAS unsigned char*)lds;
    const int wave_s = __builtin_amdgcn_readfirstlane(threadIdx.x >> 6);
    if (threadIdx.x < 2) *(LAS unsigned*)(sm + L_BARST + 4 * threadIdx.x) = 0u;
    if (threadIdx.x == 0) { const Ctx X = make_ctx(); const unsigned x = xb_xcc_id();
        *(LAS unsigned*)(sm + L_XID) = x; *(LAS unsigned*)(sm + L_XID + 4) = __hip_atomic_fetch_add(X.ctl + CW_XLOC + 64 * x, 1u, __ATOMIC_RELAXED, __HIP_MEMORY_SCOPE_AGENT); *(LAS unsigned*)(sm + L_XID + 8) = 0u; }
    __syncthreads();
    { const Ctx X = make_ctx(); (void)xcd_barrier_post(X.ctl + CW_BAR, (volatile LAS unsigned*)(sm + L_BARST)); }
    { const Ctx X = make_ctx(); phase0(X, sm, tid_of(wave_s)); }
    { const Ctx X = make_ctx(); phase_xn(X, 0, tid_of(wave_s)); }
    mk_barrier(sm);
    if (threadIdx.x == 0) {
        const Ctx X = make_ctx(); unsigned ok = 1u, nx = 0u;
        for (int j = 0; j < 16; ++j) { const unsigned c = __hip_atomic_load(X.ctl + CW_XLOC + 64 * j, __ATOMIC_RELAXED, __HIP_MEMORY_SCOPE_AGENT); if (c) { ++nx; if (c != 32u || j >= 8) ok = 0u; } }
        if (nx != 8u || gridDim.x != 256u) ok = 0u;
        *(LAS unsigned*)(sm + L_XID + 8) = ok; }
    __syncthreads();
    layer_phases<0>(grid, sm, wave_s);
    layer_phases<1>(grid, sm, wave_s);
    if (*(LAS unsigned*)(sm + L_XID + 8) == 0u) { const Ctx X = make_ctx(); phase_final(X, tid_of(wave_s)); }
}

extern "C" void kernel_launch(void* const* d_in, const int* in_sizes, int n_in, void* d_out, int out_size, void* d_ws, size_t ws_size, hipStream_t stream) {
    static int grid_blocks = 0;
    if (grid_blocks == 0) {
        int dev = 0, cus = 0, per_cu = 0;
        hipGetDevice(&dev);
        hipDeviceGetAttribute(&cus, hipDeviceAttributeMultiprocessorCount, dev);
        if (hipFuncSetAttribute((const void*)fwd_megakernel, hipFuncAttributeMaxDynamicSharedMemorySize, LDS_BYTES) != hipSuccess) { fprintf(stderr, "hipFuncSetAttribute failed\n"); }
        if (hipOccupancyMaxActiveBlocksPerMultiprocessor(&per_cu, (const void*)fwd_megakernel, 512, LDS_BYTES) != hipSuccess || per_cu < 1) { fprintf(stderr, "occupancy query: %d\n", per_cu); per_cu = 1; }
        (void)hipGetLastError();
        grid_blocks = cus * 1;
        if (ws_size < WS_END) { fprintf(stderr, "workspace too small: %zu\n", ws_size); grid_blocks = -1; }
    }
    if (grid_blocks < 0) return;
    Params p{};
    for (int i = 0; i < 24; ++i) p.in[i] = (const float*)d_in[i];
    p.out = (float*)d_out; p.ws = (unsigned char*)d_ws; p.kin = DM; p.kout = DMIX;
    if (hipMemsetAsync((char*)d_ws + WS_CTL, 0, 64 * 1024, stream) != hipSuccess) { fprintf(stderr, "memset failed\n"); return; }
    void* args[] = {&p};
    hipError_t e = hipLaunchCooperativeKernel((const void*)fwd_megakernel, dim3(grid_blocks), dim3(512), args, LDS_BYTES, stream);
    if (e != hipSuccess) fprintf(stderr, "cooperative launch failed: %s (grid %d)\n", hipGetErrorString(e), grid_blocks);
}
```

```cpp
#include <hip/hip_runtime.h>
#include <hip/hip_cooperative_groups.h>
#include <cstdio>
namespace pg8 {
#define PG8_LAS __attribute__((address_space(3)))
typedef unsigned short bf16_t;
typedef short bf16x8 __attribute__((ext_vector_type(8)));
typedef float f32x4 __attribute__((ext_vector_type(4)));
typedef unsigned u32x4 __attribute__((ext_vector_type(4)));
constexpr int BM = 256, BK = 64, HALF = 128, HTB = HALF * BK * 2  , STAGE_BYTES = 8 * HTB, NXCD = 8, WGM = 6;

__host__ __device__ __forceinline__ int lds_byte(int r, int c) { const int st = (r >> 4) * 2 + (c >> 5), rr = r & 15, cc = c & 31, ob = rr * 64 + cc * 2; return st * 1024 + (ob ^ (((ob >> 9) & 1) << 5)); }
__host__ __device__ __forceinline__ void stage_rc(int b, int& R, int& C) { const int st = b / 1024, sb = b % 1024, swz = sb ^ (((sb >> 9) & 1) << 5); R = (st >> 1) * 16 + swz / 64; C = (st & 1) * 32 + (swz % 64) / 2; }
__host__ __device__ __forceinline__ int perm32(int rho) { const int n = rho >> 4, i = rho & 15; return 8 * (i >> 2) + 4 * n + (i & 3); }

struct Unit { int pm, pn; };
struct Gemm { const bf16_t* A; const bf16_t* Bt; int M, N, K; };

struct StaticOrder {
    int nM, nN, nwg, G, c;
    __host__ __device__ void init(int M, int N, int G_, int c_) { nM = M / BM; nN = N / BM; nwg = nM * nN; G = G_; c = c_; }
    __host__ __device__ bool next(int i, Unit& u) const {
        const long L = (long)i * G + c; if (L >= nwg) return false;
        int wgid = (int)L; { const int q = nwg / NXCD, r = nwg % NXCD, xcd = wgid % NXCD, off = wgid / NXCD; wgid = (xcd < r ? xcd * (q + 1) : r * (q + 1) + (xcd - r) * q) + off; }
        const int nig = WGM * nN, gid = wgid / nig, fm = gid * WGM, gsz = (nM - fm) < WGM ? (nM - fm) : WGM;
        u.pm = fm + ((wgid % nig) % gsz); u.pn = (wgid % nig) / gsz; return true;
    }
    __device__ __forceinline__ void a_ready(const Unit&) const {}
    __device__ __forceinline__ void done(const Unit&) const {}
};
struct CountedOrder : StaticOrder {
    const unsigned* ready; unsigned need; unsigned* tmo;
    __device__ __forceinline__ void a_ready(const Unit& u) const {
        if (threadIdx.x < 64) {
            const unsigned long long t0 = __builtin_amdgcn_s_memrealtime(); unsigned polls = 0;
            while ((unsigned)__builtin_amdgcn_readfirstlane(__hip_atomic_load(ready + 64 * u.pm, __ATOMIC_RELAXED, __HIP_MEMORY_SCOPE_AGENT)) < need) {
                if ((++polls & 255u) == 0u && __builtin_amdgcn_readfirstlane(__hip_atomic_load(tmo, __ATOMIC_RELAXED, __HIP_MEMORY_SCOPE_AGENT)) != 0u) break;
                if (__builtin_amdgcn_s_memrealtime() - t0 > 2000000ull) {
                    if (threadIdx.x == 0) { unsigned expect = 0u; __hip_atomic_compare_exchange_strong(tmo + 1, &expect, 0x600u | (unsigned)(u.pm & 0xff), __ATOMIC_RELAXED, __ATOMIC_RELAXED, __HIP_MEMORY_SCOPE_AGENT); __hip_atomic_store(tmo, 1u, __ATOMIC_RELAXED, __HIP_MEMORY_SCOPE_AGENT); }
                    break; }
                __builtin_amdgcn_s_sleep(2); }
            __builtin_amdgcn_fence(__ATOMIC_ACQUIRE, "agent");
            asm volatile("s_waitcnt vmcnt(0)" ::: "memory");
        }
#if !defined(BROKEN_HOOK_NO_BARRIER)
        asm volatile("" ::: "memory"); __builtin_amdgcn_s_barrier(); asm volatile("" ::: "memory");
#endif
    }
};

typedef float cvtf2_t __attribute__((ext_vector_type(2)));
typedef __bf16 cvtb2_t __attribute__((ext_vector_type(2)));
__device__ __forceinline__ unsigned cvt_pk_bf16(float lo, float hi) { const cvtf2_t v = {lo, hi}; const cvtb2_t r = __builtin_convertvector(v, cvtb2_t); return __builtin_bit_cast(unsigned, r); }
typedef float f32x2 __attribute__((ext_vector_type(2)));
__device__ __forceinline__ f32x2 gelu_pk(f32x2 v) {
    const f32x2 av = __builtin_elementwise_abs(v), d = av * 0.2316418882f + 1.0f;
    f32x2 t; t.x = __builtin_amdgcn_rcpf(d.x); t.y = __builtin_amdgcn_rcpf(d.y);
    f32x2 q = t * 0.5307027145f + (-0.7265760135f); q = q * t + 0.7107068705f; q = q * t + (-0.142248368f); q = q * t + 0.127414796f; q = q * t;
    const f32x2 s = (v * v) * (-0.72134752044f);
    f32x2 e; e.x = __builtin_amdgcn_exp2f(s.x); e.y = __builtin_amdgcn_exp2f(s.y);
    const f32x2 m = v * (q * e), r = v - m;
    f32x2 o; o.x = v.x < 0.f ? m.x : r.x; o.y = v.y < 0.f ? m.y : r.y; return o;
}

struct EpiF32 {
    static constexpr bool PERM = false, AFTER_DRAIN = false;
    float* C; int ldc; const float* bias;
    __device__ __forceinline__ void operator()(const f32x4 (&acc)[2][2][4][2], const Unit& u, int wr, int wc, int fr, int fq) const {
        const int row0 = u.pm * BM + wr * 64 + fr, col0 = u.pn * BM + wc * 32 + 4 * fq;
        f32x4 bv[2][2];
#pragma unroll
        for (int bj = 0; bj < 2; ++bj)
#pragma unroll
            for (int n = 0; n < 2; ++n) bv[bj][n] = bias ? *(const f32x4*)(bias + col0 + bj * HALF + n * 16) : (f32x4){0.f, 0.f, 0.f, 0.f};
#pragma unroll
        for (int ai = 0; ai < 2; ++ai)
#pragma unroll
            for (int m = 0; m < 4; ++m) { float* rowp = C + (size_t)(row0 + ai * HALF + m * 16) * ldc + col0;
#pragma unroll
                for (int bj = 0; bj < 2; ++bj)
#pragma unroll
                    for (int n = 0; n < 2; ++n) *(f32x4*)(rowp + bj * HALF + n * 16) = acc[ai][bj][m][n] + bv[bj][n]; }
    }
};
template <int ACT  > struct EpiBf16 {
    static constexpr bool PERM = true, AFTER_DRAIN = false;
    bf16_t* O; int ldc; const float* bias; int split_cols; size_t split_stride;
    __device__ __forceinline__ void operator()(const f32x4 (&acc)[2][2][4][2], const Unit& u, int wr, int wc, int fr, int fq) const {
        const int row0 = u.pm * BM + wr * 64 + fr; int colt = u.pn * BM; bf16_t* base = O;
        if (split_cols) { const int t = colt / split_cols; base += (size_t)t * split_stride; colt -= t * split_cols; }
        const int col0 = colt + wc * 32 + 8 * fq, bcol0 = u.pn * BM + wc * 32 + 8 * fq;
        f32x4 bv[2][2];
#pragma unroll
        for (int bj = 0; bj < 2; ++bj)
#pragma unroll
            for (int n = 0; n < 2; ++n) bv[bj][n] = bias ? *(const f32x4*)(bias + bcol0 + bj * HALF + 4 * n) : (f32x4){0.f, 0.f, 0.f, 0.f};
#pragma unroll
        for (int ai = 0; ai < 2; ++ai)
#pragma unroll
            for (int m = 0; m < 4; ++m) { bf16_t* rowp = base + (size_t)(row0 + ai * HALF + m * 16) * ldc + col0;
#pragma unroll
                for (int bj = 0; bj < 2; ++bj) { f32x4 v0 = acc[ai][bj][m][0] + bv[bj][0], v1 = acc[ai][bj][m][1] + bv[bj][1];
                    if (ACT == 1) { f32x2 a = gelu_pk((f32x2){v0[0], v0[1]}), b = gelu_pk((f32x2){v0[2], v0[3]}), c = gelu_pk((f32x2){v1[0], v1[1]}), d = gelu_pk((f32x2){v1[2], v1[3]});
                        v0 = (f32x4){a.x, a.y, b.x, b.y}; v1 = (f32x4){c.x, c.y, d.x, d.y}; }
                    if (ACT == 2) {
#pragma unroll
                        for (int j = 0; j < 4; ++j) { v0[j] = 0.5f * v0[j] * (1.0f + erff(v0[j] * 0.70710678f)); v1[j] = 0.5f * v1[j] * (1.0f + erff(v1[j] * 0.70710678f)); } }
                    u32x4 w; w.x = cvt_pk_bf16(v0[0], v0[1]); w.y = cvt_pk_bf16(v0[2], v0[3]); w.z = cvt_pk_bf16(v1[0], v1[1]); w.w = cvt_pk_bf16(v1[2], v1[3]);
                    *(u32x4*)(rowp + bj * HALF) = w; } }
    }
};
template <class Epi, class Sched, bool STAMP = false>
__device__ __forceinline__ void gemm_phase(PG8_LAS unsigned char* lds, const Gemm g, const Sched& S, const Epi& E, unsigned long long* stamps, const int tid_in) {
    int tid_ = tid_in; asm volatile("" : "+v"(tid_));
    const int tid = tid_, wid = __builtin_amdgcn_readfirstlane(tid >> 6), lane = tid & 63, wr = wid >> 2, wc = wid & 3, fr = lane & 15, fq = lane >> 4;
    const int K = g.K, nt = K / BK;
    int ts_lo = 0, ts_hi = 0, nts = 0; const unsigned long long rt_entry = STAMP ? (unsigned long long)wall_clock64() : 0ull;
#define PG8_STAMP() do { if (STAMP && wid == 0 && nts < 64) { const unsigned long long _c = (unsigned long long)clock64(); \
        ts_lo = (lane == nts) ? (int)(unsigned)_c : ts_lo; ts_hi = (lane == nts) ? (int)(unsigned)(_c >> 32) : ts_hi; ++nts; } } while (0)
    PG8_STAMP();
    unsigned voffA[2], voffB[2];
#pragma unroll
    for (int i = 0; i < 2; ++i) { int R, C; stage_rc(tid * 16 + i * 8192, R, C); const int Rb = Epi::PERM ? ((R & ~31) + perm32(R & 31)) : R;
        voffA[i] = (unsigned)(R * K + C) * 2u; voffB[i] = (unsigned)(Rb * K + C) * 2u; }
    const size_t kstep = (size_t)(BK * 2);
    const size_t hstep = (size_t)HALF * K * 2;
    const size_t tstep = 2 * hstep;
    const unsigned ldsw = (unsigned)wid * 1024u;
    const int aoff = lds_byte(wr * 64 + fr, fq * 8), boff = lds_byte(wc * 32 + fr, fq * 8);
#define PG8_SA(b, h) (((b) * 2 + (h)) * HTB)
#define PG8_SB(b, h) ((4 + (b) * 2 + (h)) * HTB)
#define PG8_STAGE(bufoff, gbase, voff) do { _Pragma("unroll") for (int _i = 0; _i < 2; ++_i) \
        __builtin_amdgcn_global_load_lds((const unsigned*)((const char*)(gbase) + (voff)[_i]), (PG8_LAS unsigned*)(lds + (bufoff) + ldsw + _i * 8192), 16, 0, 0); } while (0)
#define PG8_LDA(dst, b, h) do { _Pragma("unroll") for (int m = 0; m < 4; ++m) _Pragma("unroll") for (int k = 0; k < 2; ++k) dst[m][k] = *(const PG8_LAS bf16x8*)(lds + PG8_SA(b, h) + aoff + m * 2048 + k * 1024); } while (0)
#define PG8_LDB(dst, b, h) do { _Pragma("unroll") for (int n = 0; n < 2; ++n) _Pragma("unroll") for (int k = 0; k < 2; ++k) dst[n][k] = *(const PG8_LAS bf16x8*)(lds + PG8_SB(b, h) + boff + n * 2048 + k * 1024); } while (0)
#define PG8_MMA(ai, bj, At, Bt) do { __builtin_amdgcn_s_setprio(1); _Pragma("unroll") for (int m = 0; m < 4; ++m) _Pragma("unroll") for (int n = 0; n < 2; ++n) _Pragma("unroll") for (int k = 0; k < 2; ++k) \
        acc[ai][bj][m][n] = __builtin_amdgcn_mfma_f32_16x16x32_bf16(Bt[n][k], At[m][k], acc[ai][bj][m][n], 0, 0, 0); __builtin_amdgcn_s_setprio(0); } while (0)
#define PG8_WAIT_V(n) asm volatile("s_waitcnt vmcnt(" #n ")" ::: "memory")
#define PG8_WAIT_L(n) asm volatile("s_waitcnt lgkmcnt(" #n ")" ::: "memory")
#define PG8_BAR __builtin_amdgcn_s_barrier()
#define PG8_SCHED __builtin_amdgcn_sched_barrier(0)
    Unit cur, nxt; int ui = 0;
    if (!S.next(0, cur)) return;
    f32x4 acc[2][2][4][2];
#pragma unroll
    for (int a = 0; a < 2; ++a)
#pragma unroll
        for (int b = 0; b < 2; ++b)
#pragma unroll
            for (int m = 0; m < 4; ++m)
#pragma unroll
                for (int n = 0; n < 2; ++n) acc[a][b][m][n] = (f32x4){0.f, 0.f, 0.f, 0.f};
    bf16x8 At[4][2], B0[2][2], B1[2][2];
    const char* cA = (const char*)g.A + (size_t)cur.pm * tstep; const char* cB = (const char*)g.Bt + (size_t)cur.pn * tstep;
    S.a_ready(cur);
    PG8_STAGE(PG8_SB(0, 0), cB, voffB); PG8_STAGE(PG8_SA(0, 0), cA, voffA); PG8_STAGE(PG8_SB(0, 1), cB + hstep, voffB); PG8_STAGE(PG8_SA(0, 1), cA + hstep, voffA);
    if (wr == 1) PG8_BAR;
    PG8_WAIT_V(4); PG8_BAR;
    PG8_STAGE(PG8_SB(1, 0), cB + kstep, voffB); PG8_STAGE(PG8_SA(1, 0), cA + kstep, voffA); PG8_STAGE(PG8_SB(1, 1), cB + hstep + kstep, voffB);
    PG8_WAIT_V(6); PG8_BAR;
    PG8_STAMP();
    for (;;) {
        const bool has_next = S.next(ui + 1, nxt);
        const char* nA = has_next ? (const char*)g.A + (size_t)nxt.pm * tstep : cA; const char* nB = has_next ? (const char*)g.Bt + (size_t)nxt.pn * tstep : cB;
        for (int t = 0; t < nt; t += 2) {
            const bool last = (t == nt - 2);
            const char* a1 = cA + (size_t)(t + 1) * kstep;
            const char* a2 = last ? nA : cA + (size_t)(t + 2) * kstep; const char* b2 = last ? nB : cB + (size_t)(t + 2) * kstep;
            const char* a3 = a2 + kstep; const char* b3 = b2 + kstep;
            if (last && has_next) S.a_ready(nxt);
            PG8_LDB(B0, 0, 0); PG8_SCHED; PG8_LDA(At, 0, 0); PG8_STAGE(PG8_SA(1, 1), a1 + hstep, voffA);
            PG8_WAIT_L(8); PG8_BAR; PG8_WAIT_L(0); PG8_MMA(0, 0, At, B0); PG8_BAR; PG8_SCHED;
            PG8_LDB(B1, 0, 1); PG8_STAGE(PG8_SB(0, 0), b2, voffB);
            PG8_BAR; PG8_WAIT_L(0); PG8_MMA(0, 1, At, B1); PG8_BAR;
            PG8_LDA(At, 0, 1); PG8_STAGE(PG8_SA(0, 0), a2, voffA);
            PG8_BAR; PG8_WAIT_L(0); PG8_MMA(1, 0, At, B0); PG8_BAR; PG8_SCHED;
            PG8_STAGE(PG8_SB(0, 1), b2 + hstep, voffB);
            PG8_WAIT_V(6); PG8_BAR; PG8_MMA(1, 1, At, B1); PG8_BAR;
            PG8_LDB(B0, 1, 0); PG8_SCHED; PG8_LDA(At, 1, 0); PG8_STAGE(PG8_SA(0, 1), a2 + hstep, voffA);
            PG8_WAIT_L(8); PG8_BAR; PG8_WAIT_L(0); PG8_MMA(0, 0, At, B0); PG8_BAR; PG8_SCHED;
            PG8_LDB(B1, 1, 1); PG8_STAGE(PG8_SB(1, 0), b3, voffB);
            PG8_BAR; PG8_WAIT_L(0); PG8_MMA(0, 1, At, B1); PG8_BAR;
            PG8_LDA(At, 1, 1); PG8_STAGE(PG8_SA(1, 0), a3, voffA);
            PG8_BAR; PG8_WAIT_L(0); PG8_MMA(1, 0, At, B0); PG8_BAR; PG8_SCHED;
            PG8_STAGE(PG8_SB(1, 1), b3 + hstep, voffB);
            PG8_WAIT_V(6); PG8_BAR; PG8_MMA(1, 1, At, B1); PG8_BAR;
        }
        PG8_STAMP();
        if constexpr (!Epi::AFTER_DRAIN) { E(acc, cur, wr, wc, fr, fq); S.done(cur); }
        PG8_STAMP();
        if (!has_next) break;
#pragma unroll
        for (int a = 0; a < 2; ++a)
#pragma unroll
            for (int b = 0; b < 2; ++b)
#pragma unroll
                for (int m = 0; m < 4; ++m)
#pragma unroll
                    for (int n = 0; n < 2; ++n) acc[a][b][m][n] = (f32x4){0.f, 0.f, 0.f, 0.f};
        cur = nxt; cA = nA; cB = nB; ++ui;
    }
    PG8_WAIT_V(0);
    if (wr == 0) PG8_BAR;
    PG8_BAR;
    if constexpr (Epi::AFTER_DRAIN) { E.fused(acc, cur, wr, wc, fr, fq, lds, wid, lane); S.done(cur); }
    PG8_STAMP();
    if (STAMP && wid == 0) { stamps[lane] = lane < nts ? (((unsigned long long)(unsigned)ts_hi << 32) | (unsigned)ts_lo) : 0ull;
        if (lane == 62) stamps[62] = rt_entry; if (lane == 63) stamps[63] = (unsigned long long)wall_clock64(); }
#undef PG8_STAMP
#undef PG8_SA
#undef PG8_SB
#undef PG8_STAGE
#undef PG8_LDA
#undef PG8_LDB
#undef PG8_MMA
#undef PG8_WAIT_V
#undef PG8_WAIT_L
#undef PG8_BAR
#undef PG8_SCHED
}
}

namespace cg = cooperative_groups;
#define LAS __attribute__((address_space(3)))
typedef unsigned short bf16_t;
typedef short bf16x8 __attribute__((ext_vector_type(8)));
typedef float f32x4 __attribute__((ext_vector_type(4)));
typedef unsigned u32x4 __attribute__((ext_vector_type(4)));
typedef unsigned u32x2 __attribute__((ext_vector_type(2)));

constexpr int DM = 1024, NTOK = 12288, NCTX = 8192, DIN = 5632, DMIX = 1536;
constexpr int LDS_BYTES = 147456;
constexpr size_t MiB = 1u << 20;
constexpr size_t WS_CTL = 0;
constexpr size_t WS_MOD = 64 * 1024;
constexpr size_t WS_ROPE = 256 * 1024;
constexpr size_t WS_WIN = 1 * MiB;
constexpr size_t WS_WOUT = 23 * MiB;
constexpr size_t WS_PROJ = 29 * MiB;
constexpr size_t WS_OF = 161 * MiB;
constexpr size_t WS_XN = 197 * MiB;
constexpr size_t WS_OB = 213 * MiB;
constexpr size_t WS_END = 249 * MiB;

struct Params { const float* in[24]; float* out; unsigned char* ws; int kin, kout; };
#if defined(__HIP_DEVICE_COMPILE__)
#define GAS1 __attribute__((address_space(1)))
#else
#define GAS1
#endif
struct ParamsG { const GAS1 float* in[24]; GAS1 float* out; GAS1 unsigned char* ws; int kin, kout; };

struct Ctx {
    const float *x_prompt, *x_sample, *state_lru, *state_hgrn, *state_ret, *c, *c_ctx, *norm_g, *w_mod, *b_mod, *w_in, *conv_w, *conv_b,
        *lru_wa, *lru_ba, *lru_wx, *lru_bx, *lru_lambda, *hgrn_lb_logits, *hgrn_norm_g, *ret_decay_logit, *ret_norm_g, *w_out, *final_g;
    float* out; unsigned* ctl; float* MOD; float* ROPE; bf16_t *WIN, *WOUT, *PROJ, *OF, *OB, *XN;
};

__device__ __forceinline__ float bf2f(bf16_t b) { return __uint_as_float(((unsigned)b) << 16); }
typedef float cvt_f2 __attribute__((ext_vector_type(2)));
typedef __bf16 cvt_b2 __attribute__((ext_vector_type(2)));
__device__ __forceinline__ unsigned pk2(float lo, float hi) { const cvt_f2 v = {lo, hi}; const cvt_b2 r = __builtin_convertvector(v, cvt_b2); return __builtin_bit_cast(unsigned, r); }
__device__ __forceinline__ unsigned f2bf(float f) { return pk2(f, f) & 0xffffu; }
__device__ __forceinline__ float frcp(float x) { return __builtin_amdgcn_rcpf(x); }
__device__ __forceinline__ int launder_v(int v) { asm volatile("" : "+v"(v)); return v; }
__device__ __forceinline__ int tid_of(int wave_s) { int z = 0; asm volatile("" : "+v"(z));
    return launder_v(wave_s * 64 + (int)__builtin_amdgcn_mbcnt_hi(~0u, __builtin_amdgcn_mbcnt_lo(~0u, (unsigned)z))); }
__device__ __forceinline__ float wave_sum(float v) {
#pragma unroll
    for (int o = 1; o < 64; o <<= 1) v += __shfl_xor(v, o);
    return v;
}
__device__ __forceinline__ float silu_f(float x) { return x * frcp(1.f + __expf(-x)); }
__device__ __forceinline__ float sigm_f(float x) { return frcp(1.f + __expf(-x)); }

__device__ __forceinline__ void p0_transpose_item(const float* W, int K, int N, bf16_t* WT, LAS float* scr, int item, int lane) {
    const int nblk = N / 32, kb = item / nblk, nb = item % nblk, k0 = 64 * kb, n0 = 32 * nb;
    float tv[32];
#pragma unroll
    for (int i = 0; i < 32; ++i) { const int kk = 2 * i + (lane >> 5); tv[i] = W[(size_t)(k0 + kk) * N + n0 + (lane & 31)]; }
#pragma unroll
    for (int i = 0; i < 32; ++i) { const int kk = 2 * i + (lane >> 5); scr[kk * 33 + (lane & 31)] = tv[i]; }
    asm volatile("s_waitcnt lgkmcnt(0)" ::: "memory");
    const int c = lane & 7;
#pragma unroll
    for (int j = 0; j < 4; ++j) { const int n = (lane >> 3) + 8 * j; const LAS float* s = scr + (8 * c) * 33 + n;
        u32x4 o; o.x = pk2(s[0 * 33], s[1 * 33]); o.y = pk2(s[2 * 33], s[3 * 33]); o.z = pk2(s[4 * 33], s[5 * 33]); o.w = pk2(s[6 * 33], s[7 * 33]);
        *(u32x4*)(WT + (size_t)(n0 + n) * K + k0 + 8 * c) = o; }
    asm volatile("s_waitcnt lgkmcnt(0)" ::: "memory");
}

constexpr int CW_MODCNT = 256;
__device__ __forceinline__ void phase0(const Ctx& X, LAS unsigned char* sm, int tid) {
    const int lane = tid & 63, wave = tid >> 6;
    const bool split = gridDim.x > 96;
    LAS float* sc = (LAS float*)(sm + 69632);
    LAS float* red = (LAS float*)(sm + 90112);
    for (int unit = blockIdx.x; unit < 96; unit += gridDim.x) {
        const int l = unit / 48, jb = unit % 48;
        __syncthreads();
        for (int idx = tid; idx < 5 * 1024; idx += 512) { const int c = idx >> 10, k = idx & 1023; const float v = (c == 0) ? X.c_ctx[k] : X.c[(c - 1) * 1024 + k]; sc[idx] = silu_f(v); }
        __syncthreads();
        const int col = jb * 64 + lane; float a0 = 0.f, a1 = 0.f, a2 = 0.f, a3 = 0.f, a4 = 0.f;
        const float* wp = X.w_mod + ((size_t)l * 1024 + wave * 128) * 3072 + col;
#pragma unroll 16
        for (int kk = 0; kk < 128; ++kk) { const float wv = wp[(size_t)kk * 3072]; const int k = wave * 128 + kk;
            a0 += sc[k] * wv; a1 += sc[1024 + k] * wv; a2 += sc[2048 + k] * wv; a3 += sc[3072 + k] * wv; a4 += sc[4096 + k] * wv; }
        red[(wave * 5 + 0) * 64 + lane] = a0; red[(wave * 5 + 1) * 64 + lane] = a1; red[(wave * 5 + 2) * 64 + lane] = a2; red[(wave * 5 + 3) * 64 + lane] = a3; red[(wave * 5 + 4) * 64 + lane] = a4;
        __syncthreads();
        if (tid < 320) { const int c = tid >> 6, ln = tid & 63; float s = 0.f;
#pragma unroll
            for (int g = 0; g < 8; ++g) s += red[(g * 5 + c) * 64 + ln];
            X.MOD[(size_t)(l * 5 + c) * 3072 + jb * 64 + ln] = s + X.b_mod[l * 3072 + jb * 64 + ln]; }
        asm volatile("s_waitcnt vmcnt(0)" ::: "memory");
        __syncthreads();
        if (tid == 0) { __builtin_amdgcn_fence(__ATOMIC_RELEASE, "agent"); asm volatile("s_waitcnt vmcnt(0)" ::: "memory");
            __hip_atomic_fetch_add(X.ctl + CW_MODCNT, 1u, __ATOMIC_RELAXED, __HIP_MEMORY_SCOPE_AGENT); }
    }
    {
        const int first = split ? 96 : 0;
        if ((int)blockIdx.x >= first) {
            const int gw = ((int)blockIdx.x - first) * 8 + wave, NGW = ((int)gridDim.x - first) * 8;
            LAS float* scr = (LAS float*)(sm + wave * 8448);
            constexpr int I_IN = 16 * 176, I_OUT = 24 * 32, NIT = I_IN + I_OUT;
            for (int it = gw; it < NIT; it += NGW) {
                int r = it;
                if (r < I_IN) p0_transpose_item(X.w_in, 1024, 5632, X.WIN, scr, r, lane);
                else { r -= I_IN; p0_transpose_item(X.w_out, 1536, 1024, X.WOUT, scr, r, lane); }
            }
        }
    }
    if (blockIdx.x == gridDim.x - 1) {
        for (int idx = tid; idx < 2048; idx += 512) { const int pos = idx >> 5, fi = idx & 31;
            const float freq = exp2f(-(float)fi * (13.287712379549449f / 32.0f));
            const float ang = (float)pos * freq; const float rev = ang * 0.15915494309189535f; const float fr = rev - floorf(rev);
            X.ROPE[2 * idx] = __builtin_amdgcn_cosf(fr); X.ROPE[2 * idx + 1] = __builtin_amdgcn_sinf(fr); }
    }
    __syncthreads();
    if (tid == 0) { unsigned sp = 0;
        while (__hip_atomic_load(X.ctl + CW_MODCNT, __ATOMIC_RELAXED, __HIP_MEMORY_SCOPE_AGENT) < 96u) { __builtin_amdgcn_s_sleep(2); if (++sp > (1u << 22)) break; }
        __builtin_amdgcn_fence(__ATOMIC_ACQUIRE, "agent"); asm volatile("s_waitcnt vmcnt(0)" ::: "memory"); }
    __syncthreads();
}
__device__ __forceinline__ void l1_weights_idle(const Ctx& X, LAS unsigned char* sm, int tid, int idle_idx, int nidle) {
    const int lane = tid & 63, wave = tid >> 6;
    if (nidle <= 0 || idle_idx < 0) return;
    const int gw = idle_idx * 8 + wave, NGW = nidle * 8;
    LAS float* scr = (LAS float*)(sm + wave * 8448);
    constexpr int I_IN = 16 * 176, I_OUT = 24 * 32, NIT = I_IN + I_OUT;
    for (int it = gw; it < NIT; it += NGW) {
        int r = it;
        if (r < I_IN) p0_transpose_item(X.w_in + (size_t)1024 * 5632, 1024, 5632, X.WIN + (size_t)5632 * 1024, scr, r, lane);
        else { r -= I_IN; p0_transpose_item(X.w_out + (size_t)1536 * 1024, 1536, 1024, X.WOUT + (size_t)1024 * 1536, scr, r, lane); }
    }
}
__device__ __forceinline__ void phase_xn(const Ctx& X, int l, int tid, int xbase = -1) {
    const int lane = tid & 63, wave = tid >> 6;
    const int gw = blockIdx.x * 8 + wave, NGW = gridDim.x * 8;
    for (int k = 0;; ++k) {
        const int row = (xbase >= 0) ? xbase + k * 8 + wave : gw + k * NGW;
        if ((xbase >= 0) ? (k >= 6) : (row >= NTOK)) break;
        const float* xr = (l == 0) ? ((row < NCTX) ? X.x_prompt + (size_t)row * DM : X.x_sample + (size_t)(row - NCTX) * DM) : X.out + (size_t)row * DM;
        const int c = (row < NCTX) ? 0 : 1 + ((row - NCTX) >> 10);
        const float* md = X.MOD + (size_t)(l * 5 + c) * 3072;
        f32x4 v[4]; float s = 0.f;
#pragma unroll
        for (int j = 0; j < 4; ++j) { v[j] = ((const f32x4*)xr)[lane + 64 * j]; s += (v[j].x * v[j].x + v[j].y * v[j].y) + (v[j].z * v[j].z + v[j].w * v[j].w); }
        f32x4 pg[4], psh[4], pscl[4];
#pragma unroll
        for (int j = 0; j < 4; ++j) { const int k0 = (lane + 64 * j) * 4; pg[j] = *(const f32x4*)(X.norm_g + l * 1024 + k0); psh[j] = *(const f32x4*)(md + k0); pscl[j] = *(const f32x4*)(md + 1024 + k0); }
        const float r = rsqrtf(wave_sum(s) * (1.f / 1024.f) + 1e-6f);
#pragma unroll
        for (int j = 0; j < 4; ++j) { const int k0 = (lane + 64 * j) * 4;
            const f32x4 g = pg[j], sh = psh[j], scl = pscl[j];
            const f32x4 y = v[j] * r * g * (scl + 1.0f) + sh;
            u32x2 o; o.x = pk2(y.x, y.y); o.y = pk2(y.z, y.w);
            *(u32x2*)(X.XN + (size_t)row * DM + k0) = o; }
    }
}

__device__ __forceinline__ void unpack8(const u32x4 p, float (&f)[8]) {
    f[0] = __uint_as_float(p.x << 16); f[1] = __uint_as_float(p.x & 0xffff0000u); f[2] = __uint_as_float(p.y << 16); f[3] = __uint_as_float(p.y & 0xffff0000u);
    f[4] = __uint_as_float(p.z << 16); f[5] = __uint_as_float(p.z & 0xffff0000u); f[6] = __uint_as_float(p.w << 16); f[7] = __uint_as_float(p.w & 0xffff0000u);
}
__device__ __forceinline__ void phase_post(const Ctx& X, int l, int tid, int xbase = -1) {
    const int lane = tid & 63, wave = tid >> 6;
    const int gw = blockIdx.x * 8 + wave, NGW = gridDim.x * 8;
    for (int k = 0;; ++k) {
        const int row = (xbase >= 0) ? xbase + k * 8 + wave : gw + k * NGW;
        if ((xbase >= 0) ? (k >= 6) : (row >= NTOK)) break;
        bf16_t* of = X.OF + (size_t)row * DMIX; const bf16_t* ob = X.OB + (size_t)row * DMIX; const bf16_t* pr = X.PROJ + (size_t)row * DIN;
        const int ch0 = lane * 8;
        u32x4 la[3], lb2[3], lg[3];
#pragma unroll
        for (int pass = 0; pass < 3; ++pass) { const int gcol = (pass == 0) ? 512 : (pass == 1) ? 3072 : 5120;
            la[pass] = *(const u32x4*)(of + pass * 512 + ch0); lb2[pass] = *(const u32x4*)(ob + pass * 512 + ch0); lg[pass] = *(const u32x4*)(pr + gcol + ch0); }
#pragma unroll
        for (int pass = 0; pass < 3; ++pass) {
            float a[8], b[8], g[8], y[8];
            unpack8(la[pass], a); unpack8(lb2[pass], b); unpack8(lg[pass], g);
            float ss = 0.f;
#pragma unroll
            for (int j = 0; j < 8; ++j) { y[j] = a[j] + b[j]; ss += y[j] * y[j]; }
            if (pass > 0) {
                ss += __shfl_xor(ss, 1); ss += __shfl_xor(ss, 2); ss += __shfl_xor(ss, 4); ss += __shfl_xor(ss, 8);
                const float rn = rsqrtf(ss * (1.f / 128.f) + 1e-6f);
                const float* ng = ((pass == 1) ? X.hgrn_norm_g : X.ret_norm_g) + l * 512 + ch0;
                const f32x4 g0 = *(const f32x4*)ng, g1 = *(const f32x4*)(ng + 4);
                y[0] *= rn * g0.x; y[1] *= rn * g0.y; y[2] *= rn * g0.z; y[3] *= rn * g0.w; y[4] *= rn * g1.x; y[5] *= rn * g1.y; y[6] *= rn * g1.z; y[7] *= rn * g1.w;
            }
#pragma unroll
            for (int j = 0; j < 8; ++j) y[j] *= (pass == 2 && ch0 >= 256 && row < NCTX) ? silu_f(g[j]) : g[j];
            u32x4 o; o.x = pk2(y[0], y[1]); o.y = pk2(y[2], y[3]); o.z = pk2(y[4], y[5]); o.w = pk2(y[6], y[7]);
            *(u32x4*)(of + pass * 512 + ch0) = o;
        }
    }
}

__device__ __forceinline__ void phase_final(const Ctx& X, int tid, int xbase = -1) {
    const int lane = tid & 63, wave = tid >> 6;
    const int gw = blockIdx.x * 8 + wave, NGW = gridDim.x * 8;
    for (int k = 0;; ++k) {
        const int row = (xbase >= 0) ? xbase + k * 8 + wave : gw + k * NGW;
        if ((xbase >= 0) ? (k >= 6) : (row >= NTOK)) break;
        float* xr = X.out + (size_t)row * DM;
        f32x4 v[4]; float s = 0.f;
#pragma unroll
        for (int j = 0; j < 4; ++j) { v[j] = ((const f32x4*)xr)[lane + 64 * j]; s += (v[j].x * v[j].x + v[j].y * v[j].y) + (v[j].z * v[j].z + v[j].w * v[j].w); }
        f32x4 fg[4];
#pragma unroll
        for (int j = 0; j < 4; ++j) fg[j] = *(const f32x4*)(X.final_g + (lane + 64 * j) * 4);
        const float r = rsqrtf(wave_sum(s) * (1.f / 1024.f) + 1e-6f);
#pragma unroll
        for (int j = 0; j < 4; ++j) ((f32x4*)xr)[lane + 64 * j] = v[j] * r * fg[j];
    }
}

struct EpiResid {
    static constexpr bool PERM = false, AFTER_DRAIN = false;
    const float* xp; const float* xs; float* out; const float* modl; int layer;
    __device__ __forceinline__ void operator()(const pg8::f32x4 (&acc)[2][2][4][2], const pg8::Unit& u, int wr, int wc, int fr, int fq) const {
        const int row0 = u.pm * 256 + wr * 64 + fr, col0 = u.pn * 256 + wc * 32 + 4 * fq;
        const int c = (u.pm < 32) ? 0 : 1 + ((u.pm - 32) >> 2);
        const float* gate = modl + (size_t)c * 3072 + 2048 + col0;
        pg8::f32x4 gv[2][2];
#pragma unroll
        for (int bj = 0; bj < 2; ++bj)
#pragma unroll
            for (int n = 0; n < 2; ++n) gv[bj][n] = *(const pg8::f32x4*)(gate + bj * 128 + n * 16);
#pragma unroll
        for (int ai = 0; ai < 2; ++ai)
#pragma unroll
            for (int mp = 0; mp < 2; ++mp) {
                pg8::f32x4 xv[2][2][2];
#pragma unroll
                for (int mm = 0; mm < 2; ++mm) { const int row = row0 + ai * 128 + (mp * 2 + mm) * 16;
                    const float* xr = (layer == 0) ? ((row < NCTX) ? xp + (size_t)row * DM : xs + (size_t)(row - NCTX) * DM) : out + (size_t)row * DM;
#pragma unroll
                    for (int bj = 0; bj < 2; ++bj)
#pragma unroll
                        for (int n = 0; n < 2; ++n) xv[mm][bj][n] = *(const pg8::f32x4*)(xr + col0 + bj * 128 + n * 16); }
                asm volatile("" ::: "memory");
#pragma unroll
                for (int mm = 0; mm < 2; ++mm) { float* orow = out + (size_t)(row0 + ai * 128 + (mp * 2 + mm) * 16) * DM;
#pragma unroll
                    for (int bj = 0; bj < 2; ++bj)
#pragma unroll
                        for (int n = 0; n < 2; ++n) *(pg8::f32x4*)(orow + col0 + bj * 128 + n * 16) = xv[mm][bj][n] + gv[bj][n] * acc[ai][bj][mp * 2 + mm][n]; }
                asm volatile("" ::: "memory");
            }
    }
};

template <int FIXED_ACT> struct EpiProjT {
    static constexpr bool PERM = true, AFTER_DRAIN = false;
    bf16_t* O;
    __device__ __forceinline__ void operator()(const pg8::f32x4 (&acc)[2][2][4][2], const pg8::Unit& u, int wr, int wc, int fr, int fq) const {
        const int row0 = u.pm * 256 + wr * 64 + fr; const int col0 = u.pn * 256 + wc * 32 + 8 * fq;
        const int act = (FIXED_ACT >= 0) ? FIXED_ACT : (u.pn == 2 || u.pn == 3 || u.pn == 4 || u.pn == 5 || u.pn == 12 || u.pn == 13 || u.pn == 20 || u.pn == 21) ? 1 : (u.pn >= 6 && u.pn <= 9) ? 2 : 0;
#pragma unroll
        for (int ai = 0; ai < 2; ++ai)
#pragma unroll
            for (int m = 0; m < 4; ++m) { bf16_t* rowp = O + (size_t)(row0 + ai * 128 + m * 16) * DIN + col0;
#pragma unroll
                for (int bj = 0; bj < 2; ++bj) { pg8::f32x4 v0 = acc[ai][bj][m][0], v1 = acc[ai][bj][m][1];
                    if (act == 1) {
#pragma unroll
                        for (int j = 0; j < 4; ++j) { v0[j] = silu_f(v0[j]); v1[j] = silu_f(v1[j]); } }
                    else if (act == 2) {
#pragma unroll
                        for (int j = 0; j < 4; ++j) { v0[j] = __expf(-fmaxf(v0[j], -80.f)); v1[j] = __expf(-fmaxf(v1[j], -80.f)); } }
                    u32x4 w4; w4.x = pk2(v0[0], v0[1]); w4.y = pk2(v0[2], v0[3]); w4.z = pk2(v1[0], v1[1]); w4.w = pk2(v1[2], v1[3]);
                    *(u32x4*)(rowp + bj * 128) = w4; } }
    }
};

#define MFMA16(a, b, c) __builtin_amdgcn_mfma_f32_16x16x32_bf16((a), (b), (c), 0, 0, 0)
constexpr int G_QM = 0, G_QS = 17408, G_KM = 34816, G_KT = 52224, G_VT = 68608, G_ST = 84992, G_AT = 119808, G_GD = 129024, G_SEG = 129536;
constexpr int L_MISC = 140000;

__device__ __forceinline__ void unpack8v(const u32x4 p, float (&f)[8]) {
    f[0] = __uint_as_float(p.x << 16); f[1] = __uint_as_float(p.x & 0xffff0000u); f[2] = __uint_as_float(p.y << 16); f[3] = __uint_as_float(p.y & 0xffff0000u);
    f[4] = __uint_as_float(p.z << 16); f[5] = __uint_as_float(p.z & 0xffff0000u); f[6] = __uint_as_float(p.w << 16); f[7] = __uint_as_float(p.w & 0xffff0000u);
}
__device__ __forceinline__ u32x4 pack8v(const float (&f)[8]) { u32x4 o; o.x = pk2(f[0], f[1]); o.y = pk2(f[2], f[3]); o.z = pk2(f[4], f[5]); o.w = pk2(f[6], f[7]); return o; }

template <bool ISRET, bool ROPE> __device__ __forceinline__ void gla_item(const Ctx& X, const int l, const int isdec, const int seq, const int hgl, const int dir, LAS unsigned char* sm, const int tid, unsigned* ctr, unsigned& nxt) {
    const int lane = tid & 63, w = __builtin_amdgcn_readfirstlane(tid >> 6);
    const int c8 = lane & 15, g = lane >> 4, d0 = c8 * 8, i0 = (4 * w + g) * 2;
    const int L = isdec ? 1024 : 256, row0 = isdec ? NCTX + seq * 1024 : seq * 256, nch = L >> 6;
    constexpr bool isret = ISRET; const int h = hgl & 3;
    const unsigned qcol = (unsigned)((isret ? 3584 : 1024) + h * 128 + d0);
    const unsigned zcol = (unsigned)((isret ? 4096 : (dir ? 2048 : 1536)) + h * 128 + d0);
    const unsigned vcol = (unsigned)((isret ? 4608 : 2560) + h * 128 + d0);
    const int ocol = 512 + hgl * 128;
    bf16_t* OUT = dir ? X.OB : X.OF;
    float lbv[8]; float gam = 1.f;
#pragma unroll
    for (int c = 0; c < 8; ++c) lbv[c] = 0.f;
    if (!isret) { if (l == 1) {
#pragma unroll
            for (int c = 0; c < 8; ++c) { const float a0 = X.hgrn_lb_logits[(0 * 2 + dir) * 512 + h * 128 + d0 + c], a1 = X.hgrn_lb_logits[(1 * 2 + dir) * 512 + h * 128 + d0 + c]; lbv[c] = frcp(1.f + __expf(a0 - a1)); } } }
    else { gam = sigm_f(X.ret_decay_logit[(l * 2 + dir) * 4 + h]); }
    const float lg2 = log2f(gam), g32 = exp2f(32.0f * lg2);
    const int quad = lane >> 4, r16 = lane & 15;
    const int tr = w >> 1, cbk = w & 1, dtb = 2 * (w >> 1), etb = (w & 1) * 4;
    f32x4 S[2][4];
    if (isdec) {
        const float* st = (isret ? X.state_ret : X.state_hgrn) + (size_t)((((seq * 2 + l) * 2 + dir) * 4 + h) * 128) * 128;
#pragma unroll
        for (int a = 0; a < 2; ++a)
#pragma unroll
            for (int b = 0; b < 4; ++b)
#pragma unroll
                for (int j = 0; j < 4; ++j) S[a][b][j] = st[((dtb + a) * 16 + quad * 4 + j) * 128 + (etb + b) * 16 + r16];
    } else {
#pragma unroll
        for (int a = 0; a < 2; ++a)
#pragma unroll
            for (int b = 0; b < 4; ++b) S[a][b] = (f32x4){0.f, 0.f, 0.f, 0.f};
    }
#pragma unroll
    for (int a = 0; a < 2; ++a)
#pragma unroll
        for (int b = 0; b < 4; ++b) { u32x2 o; o.x = pk2(S[a][b][0], S[a][b][1]); o.y = pk2(S[a][b][2], S[a][b][3]);
            *(LAS u32x2*)(sm + G_ST + ((etb + b) * 16 + r16) * 272 + ((dtb + a) * 16 + quad * 4) * 2) = o; }
    u32x4 rq[2], rz[2], rv[2];
#define GLA_LOAD(ci) do { const int cb_ = dir ? (nch - 1 - (ci)) * 64 : (ci) * 64; \
        _Pragma("unroll") for (int tt = 0; tt < 2; ++tt) { const int t_ = dir ? cb_ + 63 - (i0 + tt) : cb_ + i0 + tt; const unsigned ro_ = (unsigned)(row0 + t_) * (unsigned)DIN; \
            rq[tt] = *(const u32x4*)(X.PROJ + ro_ + qcol); rz[tt] = *(const u32x4*)(X.PROJ + ro_ + zcol); rv[tt] = *(const u32x4*)(X.PROJ + ro_ + vcol); } } while (0)
    GLA_LOAD(0);
    for (int ci = 0; ci < nch; ++ci) {
        const int cb = dir ? (nch - 1 - ci) * 64 : ci * 64;
        if (ci == nch - 1 && tid == 0) nxt = atomicAdd(ctr, 1u);
        float qq[2][8], kk[2][8], cum[2][8];
        {
            float ff[2][8];
#pragma unroll
            for (int tt = 0; tt < 2; ++tt) {
                float qr[8], zr[8]; unpack8v(rq[tt], qr); unpack8v(rz[tt], zr);
                if (!isret) {
#pragma unroll
                    for (int c = 0; c < 8; ++c) { const float e = zr[c]; const float sg = frcp(1.f + e); const float oml = 1.f - lbv[c];
                        ff[tt][c] = fmaxf(lbv[c] + oml * sg, 1e-20f); kk[tt][c] = oml * (e * sg); qq[tt][c] = qr[c]; }
                } else {
                    if constexpr (ROPE) { const int t_ = dir ? cb + 63 - (i0 + tt) : cb + i0 + tt; const int pos = (c8 < 8) ? (t_ >> 6) : (t_ & 63);
                        const float* rp = X.ROPE + 2 * (pos * 32 + 8 * (c8 & 3));
                        const f32x4 cs0 = *(const f32x4*)(rp), cs1 = *(const f32x4*)(rp + 4), cs2 = *(const f32x4*)(rp + 8), cs3 = *(const f32x4*)(rp + 12);
                        const float cc[8] = {cs0.x, cs0.z, cs1.x, cs1.z, cs2.x, cs2.z, cs3.x, cs3.z}, ss[8] = {cs0.y, cs0.w, cs1.y, cs1.w, cs2.y, cs2.w, cs3.y, cs3.w};
                        const bool first = (c8 & 4) == 0;
#pragma unroll
                        for (int c = 0; c < 8; ++c) { const float qo = __shfl_xor(qr[c], 4), ko = __shfl_xor(zr[c], 4);
                            qr[c] = first ? qr[c] * cc[c] - qo * ss[c] : qo * ss[c] + qr[c] * cc[c];
                            zr[c] = first ? zr[c] * cc[c] - ko * ss[c] : ko * ss[c] + zr[c] * cc[c]; } }
                    const float pt = exp2f((float)(i0 + tt - 31) * lg2);
#pragma unroll
                    for (int c = 0; c < 8; ++c) { cum[tt][c] = pt; kk[tt][c] = zr[c]; qq[tt][c] = qr[c] * 0.08838834764831845f; }
                }
            }
            if (!isret) {
            float wt[8];
#pragma unroll
            for (int c = 0; c < 8; ++c) { const float tot = ff[0][c] * ff[1][c]; float inc = tot;
                float u = __shfl_up(inc, 16); if (g >= 1) inc *= u;
                u = __shfl_up(inc, 32); if (g >= 2) inc *= u;
                float exc = __shfl_up(inc, 16); if (g == 0) exc = 1.f;
                cum[0][c] = exc * ff[0][c]; cum[1][c] = inc; wt[c] = inc; }
            if (g == 3) { *(LAS f32x4*)(sm + G_SEG + (w * 128 + d0) * 4) = (f32x4){wt[0], wt[1], wt[2], wt[3]}; *(LAS f32x4*)(sm + G_SEG + (w * 128 + d0 + 4) * 4) = (f32x4){wt[4], wt[5], wt[6], wt[7]}; }
            }
        }
        __syncthreads();
        {
            float Eref[8], E47[8], Mq[8];
            if (isret) {
#pragma unroll
                for (int c = 0; c < 8; ++c) { Eref[c] = g32; E47[c] = g32; Mq[c] = 1.f; }
            } else {
#pragma unroll
                for (int c = 0; c < 8; ++c) { Eref[c] = 1.f; E47[c] = 1.f; Mq[c] = 1.f; }
#pragma unroll
                for (int k = 3; k >= 0; --k) { const f32x4 a = *(LAS f32x4*)(sm + G_SEG + (k * 128 + d0) * 4), b = *(LAS f32x4*)(sm + G_SEG + (k * 128 + d0 + 4) * 4);
                    Eref[0] *= a.x; Eref[1] *= a.y; Eref[2] *= a.z; Eref[3] *= a.w; Eref[4] *= b.x; Eref[5] *= b.y; Eref[6] *= b.z; Eref[7] *= b.w;
                    if (w == k) {
#pragma unroll
                        for (int c = 0; c < 8; ++c) Mq[c] = Eref[c]; } }
#pragma unroll
                for (int k = 4; k < 8; ++k) { const f32x4 a = *(LAS f32x4*)(sm + G_SEG + (k * 128 + d0) * 4), b = *(LAS f32x4*)(sm + G_SEG + (k * 128 + d0 + 4) * 4);
                    if (w == k) {
#pragma unroll
                        for (int c = 0; c < 8; ++c) Mq[c] = E47[c]; }
                    E47[0] *= a.x; E47[1] *= a.y; E47[2] *= a.z; E47[3] *= a.w; E47[4] *= b.x; E47[5] *= b.y; E47[6] *= b.z; E47[7] *= b.w; }
                if (w < 4) {
#pragma unroll
                    for (int c = 0; c < 8; ++c) Mq[c] = frcp(Mq[c]); }
            }
            if (w == 0 && g == 0) { *(LAS f32x4*)(sm + G_GD + d0 * 4) = (f32x4){Eref[0] * E47[0], Eref[1] * E47[1], Eref[2] * E47[2], Eref[3] * E47[3]};
                *(LAS f32x4*)(sm + G_GD + (d0 + 4) * 4) = (f32x4){Eref[4] * E47[4], Eref[5] * E47[5], Eref[6] * E47[6], Eref[7] * E47[7]}; }
            unsigned ktp[8], vtp[8]; float ks0[8];
#pragma unroll
            for (int tt = 0; tt < 2; ++tt) {
                float qm[8], qs[8], km[8];
#pragma unroll
                for (int c = 0; c < 8; ++c) { const float P = cum[tt][c] * Mq[c]; qm[c] = qq[tt][c] * P; qs[c] = qm[c] * Eref[c]; km[c] = kk[tt][c] * frcp(P);
                    const float ksv = km[c] * E47[c];
                    if (tt == 0) ks0[c] = ksv; else ktp[c] = pk2(ks0[c], ksv); }
                *(LAS u32x4*)(sm + G_QM + (i0 + tt) * 272 + d0 * 2) = pack8v(qm);
                *(LAS u32x4*)(sm + G_QS + (i0 + tt) * 272 + d0 * 2) = pack8v(qs);
                *(LAS u32x4*)(sm + G_KM + (i0 + tt) * 272 + d0 * 2) = pack8v(km);
            }
            {
                const unsigned a0 = rv[0].x, a1 = rv[0].y, a2 = rv[0].z, a3 = rv[0].w, b0 = rv[1].x, b1 = rv[1].y, b2 = rv[1].z, b3 = rv[1].w;
                vtp[0] = (a0 & 0xffffu) | (b0 << 16); vtp[1] = (a0 >> 16) | (b0 & 0xffff0000u); vtp[2] = (a1 & 0xffffu) | (b1 << 16); vtp[3] = (a1 >> 16) | (b1 & 0xffff0000u);
                vtp[4] = (a2 & 0xffffu) | (b2 << 16); vtp[5] = (a2 >> 16) | (b2 & 0xffff0000u); vtp[6] = (a3 & 0xffffu) | (b3 << 16); vtp[7] = (a3 >> 16) | (b3 & 0xffff0000u);
            }
            const int swz = ((w ^ (c8 & 7)) * 16) + 4 * g;
#pragma unroll
            for (int c = 0; c < 8; ++c) { *(LAS unsigned*)(sm + G_KT + (d0 + c) * 128 + swz) = ktp[c]; *(LAS unsigned*)(sm + G_VT + (d0 + c) * 128 + swz) = vtp[c]; }
        }
        if (ci + 1 < nch) GLA_LOAD(ci + 1);
        __syncthreads();
        f32x4 O[4];
        {
            bf16x8 aq[4];
#pragma unroll
            for (int ks = 0; ks < 4; ++ks) aq[ks] = *(LAS bf16x8*)(sm + G_QM + (tr * 16 + r16) * 272 + (ks * 32 + quad * 8) * 2);
#pragma unroll
            for (int tt = 0; tt < 2; ++tt) { const int tc = cbk * 2 + tt; f32x4 acc = (f32x4){0.f, 0.f, 0.f, 0.f};
                if (tc <= tr) {
#pragma unroll
                    for (int ks = 0; ks < 4; ++ks) { const bf16x8 bfr = *(LAS bf16x8*)(sm + G_KM + (tc * 16 + r16) * 272 + (ks * 32 + quad * 8) * 2); acc = MFMA16(aq[ks], bfr, acc); } }
#pragma unroll
                for (int j = 0; j < 4; ++j) { const int row = tr * 16 + quad * 4 + j, col = tc * 16 + r16; const float v = (col <= row) ? acc[j] : 0.f;
                    *(LAS bf16_t*)(sm + G_AT + row * 144 + col * 2) = (bf16_t)f2bf(v); } }
#pragma unroll
            for (int ks = 0; ks < 4; ++ks) aq[ks] = *(LAS bf16x8*)(sm + G_QS + (tr * 16 + r16) * 272 + (ks * 32 + quad * 8) * 2);
#pragma unroll
            for (int b = 0; b < 4; ++b) { O[b] = (f32x4){0.f, 0.f, 0.f, 0.f};
#pragma unroll
                for (int ks = 0; ks < 4; ++ks) { const bf16x8 afr = *(LAS bf16x8*)(sm + G_ST + ((etb + b) * 16 + r16) * 272 + (ks * 32 + quad * 8) * 2); O[b] = MFMA16(afr, aq[ks], O[b]); } }
        }
        __syncthreads();
        {
            const int nks = (tr >= 2) ? 2 : 1;
            for (int ks = 0; ks < nks; ++ks) { const bf16x8 bt = *(LAS bf16x8*)(sm + G_AT + (tr * 16 + r16) * 144 + (ks * 32 + quad * 8) * 2);
#pragma unroll
                for (int b = 0; b < 4; ++b) { const int R = (etb + b) * 16 + r16; const bf16x8 afr = *(LAS bf16x8*)(sm + G_VT + R * 128 + ((((ks * 4 + quad) ^ (R >> 3)) & 7) * 16)); O[b] = MFMA16(afr, bt, O[b]); } }
            {
                const int i_ = tr * 16 + r16; const int t_ = dir ? cb + 63 - i_ : cb + i_;
                bf16_t* op = OUT + (size_t)(row0 + t_) * DMIX + ocol + etb * 16 + quad * 4;
#pragma unroll
                for (int b = 0; b < 4; ++b) { u32x2 o; o.x = pk2(O[b][0], O[b][1]); o.y = pk2(O[b][2], O[b][3]); *(u32x2*)(op + b * 16) = o; }
            }
#pragma unroll
            for (int a = 0; a < 2; ++a) { const f32x4 g4 = *(LAS f32x4*)(sm + G_GD + ((dtb + a) * 16 + quad * 4) * 4);
#pragma unroll
                for (int b = 0; b < 4; ++b) S[a][b] = S[a][b] * g4; }
#pragma unroll
            for (int ks = 0; ks < 2; ++ks) {
                bf16x8 bfr[4];
#pragma unroll
                for (int b = 0; b < 4; ++b) { const int R = (etb + b) * 16 + r16; bfr[b] = *(LAS bf16x8*)(sm + G_VT + R * 128 + ((((ks * 4 + quad) ^ (R >> 3)) & 7) * 16)); }
#pragma unroll
                for (int a = 0; a < 2; ++a) { const int R = (dtb + a) * 16 + r16; const bf16x8 af = *(LAS bf16x8*)(sm + G_KT + R * 128 + ((((ks * 4 + quad) ^ (R >> 3)) & 7) * 16));
#pragma unroll
                    for (int b = 0; b < 4; ++b) S[a][b] = MFMA16(af, bfr[b], S[a][b]); } }
#pragma unroll
            for (int a = 0; a < 2; ++a)
#pragma unroll
                for (int b = 0; b < 4; ++b) { u32x2 o; o.x = pk2(S[a][b][0], S[a][b][1]); o.y = pk2(S[a][b][2], S[a][b][3]);
                    *(LAS u32x2*)(sm + G_ST + ((etb + b) * 16 + r16) * 272 + ((dtb + a) * 16 + quad * 4) * 2) = o; }
        }
    }
#undef GLA_LOAD
    if (!isdec) {
        float* fo = X.out + (isret ? 21037056 : 12648448) + (size_t)((((seq * 2 + l) * 2 + dir) * 4 + h) * 128) * 128;
#pragma unroll
        for (int a = 0; a < 2; ++a)
#pragma unroll
            for (int b = 0; b < 4; ++b)
#pragma unroll
                for (int j = 0; j < 4; ++j) fo[((dtb + a) * 16 + quad * 4 + j) * 128 + (etb + b) * 16 + r16] = S[a][b][j];
    }
}

constexpr int R_U = 0, R_WT = 18432, R_GT = 36864, R_SA = 104448, R_SB = 108544, R_HC = 112640;
__device__ __forceinline__ void lru_item(const Ctx& X, const int l, const int isdec, const int seq, const int hb, const int dir, LAS unsigned char* sm, const int tid, unsigned* ctr, unsigned& nxt) {
    const int lane = tid & 63, w = __builtin_amdgcn_readfirstlane(tid >> 6);
    const int ch = lane, tq = w;
    const int L = isdec ? 1024 : 256, row0 = isdec ? NCTX + seq * 1024 : seq * 256, nch = L >> 7;
    const int gch = hb * 64 + ch;
    bf16_t* OUT = dir ? X.OB : X.OF;
    {
        const float* wa = X.lru_wa + (size_t)(((l * 2 + dir) * 8 + hb) * 64) * 64; const float* wx = X.lru_wx + (size_t)(((l * 2 + dir) * 8 + hb) * 64) * 64;
        float wv[16];
#pragma unroll
        for (int q = 0; q < 16; ++q) { const int idx = tid + 512 * q; const int which = idx >> 12, k = (idx >> 6) & 63, n = idx & 63; wv[q] = (which ? wx : wa)[k * 64 + n]; }
#pragma unroll
        for (int q = 0; q < 16; ++q) { const int idx = tid + 512 * q; const int which = idx >> 12, k = (idx >> 6) & 63, n = idx & 63;
            *(LAS bf16_t*)(sm + R_WT + (which * 64 + n) * 144 + k * 2) = (bf16_t)f2bf(wv[q]); }
    }
    const float w0 = X.conv_w[(l * 4 + 0) * 512 + gch], w1 = X.conv_w[(l * 4 + 1) * 512 + gch], w2 = X.conv_w[(l * 4 + 2) * 512 + gch], w3 = X.conv_w[(l * 4 + 3) * 512 + gch];
    const float cbias = X.conv_b[l * 512 + gch];
    const float wq0 = dir ? w3 : 0.f, wq1 = dir ? w2 : w0, wq2 = w1, wq3 = dir ? w0 : w2, wq4 = dir ? 0.f : w3;
    const float ba = X.lru_ba[(l * 2 + dir) * 512 + gch], bx = X.lru_bx[(l * 2 + dir) * 512 + gch];
    const float lam = X.lru_lambda[(l * 2 + dir) * 512 + gch];
    const float sp = (lam > 15.f) ? __expf(-lam) : log1pf(__expf(-lam));
    if (tq == 0) *(LAS float*)(sm + R_HC + ch * 4) = isdec ? X.state_lru[((seq * 2 + l) * 2 + dir) * 512 + gch] : 0.f;
    const int quad = lane >> 4, r16 = lane & 15;
    const int sgn = dir ? -1 : 1;
    bf16_t ext[20];
#define LRU_LOAD(ci) do { const int cb_ = dir ? (nch - 1 - (ci)) * 128 : (ci) * 128; const int tb_ = dir ? cb_ + 127 - tq * 16 : cb_ + tq * 16; \
        _Pragma("unroll") for (int q = 0; q < 20; ++q) { const int t_ = tb_ + sgn * (q - 2); ext[q] = (t_ >= 0 && t_ < L) ? X.PROJ[(size_t)(row0 + t_) * DIN + gch] : (bf16_t)0; } } while (0)
    LRU_LOAD(0);
    __syncthreads();
    float hfin = 0.f;
    for (int ci = 0; ci < nch; ++ci) {
        if (ci == nch - 1 && tid == 0) nxt = atomicAdd(ctr, 1u);
        const int cb = dir ? (nch - 1 - ci) * 128 : ci * 128; const int tb = dir ? cb + 127 - tq * 16 : cb + tq * 16;
        const int par = ci & 1;
        float uu[16];
        { float xe[20];
#pragma unroll
          for (int q = 0; q < 20; ++q) xe[q] = bf2f(ext[q]);
          if (ci + 1 < nch) LRU_LOAD(ci + 1);
#pragma unroll
          for (int j = 0; j < 16; ++j) { uu[j] = cbias + wq0 * xe[j] + wq1 * xe[j + 1] + wq2 * xe[j + 2] + wq3 * xe[j + 3] + wq4 * xe[j + 4];
              *(LAS bf16_t*)(sm + R_U + (tq * 16 + j) * 144 + ch * 2) = (bf16_t)f2bf(uu[j]); } }
        {
            f32x4 acc[8];
#pragma unroll
            for (int b = 0; b < 8; ++b) acc[b] = (f32x4){0.f, 0.f, 0.f, 0.f};
#pragma unroll
            for (int ks = 0; ks < 2; ++ks) { const bf16x8 af = *(LAS bf16x8*)(sm + R_U + (tq * 16 + r16) * 144 + (ks * 32 + quad * 8) * 2);
#pragma unroll
                for (int b = 0; b < 8; ++b) { const bf16x8 bfr = *(LAS bf16x8*)(sm + R_WT + (b * 16 + r16) * 144 + (ks * 32 + quad * 8) * 2); acc[b] = MFMA16(af, bfr, acc[b]); } }
#pragma unroll
            for (int b = 0; b < 8; ++b)
#pragma unroll
                for (int j = 0; j < 4; ++j) *(LAS float*)(sm + R_GT + ((tq * 16 + quad * 4 + j) * 132 + b * 16 + r16) * 4) = acc[b][j];
        }
        float aa[16], bb[16]; float Al = 1.f, Bl = 0.f;
#pragma unroll
        for (int j = 0; j < 16; ++j) { const int i_ = tq * 16 + j;
            const float prr = *(LAS float*)(sm + R_GT + (i_ * 132 + ch) * 4) + ba, pri = *(LAS float*)(sm + R_GT + (i_ * 132 + 64 + ch) * 4) + bx;
            const float rg = sigm_f(prr), ig = sigm_f(pri);
            const float la = -8.0f * rg * sp; const float a = __expf(la);
            const float om = fmaf(-a, a, 1.0f);
            const float b = __builtin_amdgcn_sqrtf(om) * (ig * uu[j]);
            aa[j] = a; bb[j] = b; Al *= a; Bl = a * Bl + b; }
        *(LAS float*)(sm + R_SA + ((par * 8 + tq) * 64 + ch) * 4) = Al; *(LAS float*)(sm + R_SB + ((par * 8 + tq) * 64 + ch) * 4) = Bl;
        __syncthreads();
        float hh = *(LAS float*)(sm + R_HC + (par * 64 + ch) * 4);
        { float sa[7], sb[7];
#pragma unroll
          for (int s = 0; s < 7; ++s) { sa[s] = *(LAS float*)(sm + R_SA + ((par * 8 + s) * 64 + ch) * 4); sb[s] = *(LAS float*)(sm + R_SB + ((par * 8 + s) * 64 + ch) * 4); }
#pragma unroll
          for (int s = 0; s < 7; ++s) if (s < tq) hh = sa[s] * hh + sb[s]; }
#pragma unroll
        for (int j = 0; j < 16; ++j) { hh = aa[j] * hh + bb[j]; const int t_ = tb + sgn * j; OUT[(size_t)(row0 + t_) * DMIX + gch] = (bf16_t)f2bf(hh); }
        hfin = hh;
        if (tq == 7) *(LAS float*)(sm + R_HC + ((par ^ 1) * 64 + ch) * 4) = hh;
    }
#undef LRU_LOAD
    if (!isdec && tq == 7) X.out[12582912 + ((seq * 2 + l) * 2 + dir) * 512 + gch] = hfin;
}


struct InProjOrder : pg8::StaticOrder {
    __device__ bool next(int i, pg8::Unit& u) const {
        const long Lq = (long)i * G + c;
        if (Lq < 1008) return pg8::StaticOrder::next(i, u);
        if (Lq < 1024) { u.pm = 32 + (int)(Lq - 1008); u.pn = 21; return true; }
        return false;
    }
};
struct OneUnit {
    int pm, pn;
    __device__ bool next(int i, pg8::Unit& u) const { if (i > 0) return false; u.pm = pm; u.pn = pn; return true; }
    __device__ __forceinline__ void a_ready(const pg8::Unit&) const {}
    __device__ __forceinline__ void done(const pg8::Unit&) const {}
};
__device__ __forceinline__ void phase_mixer(const Ctx& X, const int l, LAS unsigned char* sm, const int tid, const int kin) {
    unsigned* ctr = X.ctl + 64 * l;
    __syncthreads();
    if (tid == 0) *(LAS unsigned*)(sm + L_MISC) = atomicAdd(ctr, 1u);
    __syncthreads();
    int it = (int)__builtin_amdgcn_readfirstlane(*(LAS unsigned*)(sm + L_MISC));
    while (it < 1184) {
        unsigned nxt = 0u;
        __syncthreads();
        if (it < 32) {
            if (tid == 0) nxt = atomicAdd(ctr, 1u);
            pg8::Gemm g{X.XN, X.WIN + (size_t)l * DIN * DM, NTOK, DIN, kin}; OneUnit S{it, 21};
            pg8::EpiBf16<0> E{X.PROJ, DIN, nullptr, 0, 0};
            pg8::gemm_phase<pg8::EpiBf16<0>, OneUnit, false>(sm, g, S, E, nullptr, launder_v(tid));
        } else {
            const int it2 = it - 32;
            const int isdec = (it2 < 128) ? 1 : 0; const int k = isdec ? it2 : it2 - 128; const int per = isdec ? 64 : 512;
            const int kind = (k >= per) ? 1 : 0; const int kk = kind ? k - per : k;
            const int tid2 = launder_v(tid);
            if (kind == 0) { const int hgl_ = (kk >> 1) & 7;
                if (hgl_ < 4) gla_item<false, false>(X, l, isdec, kk >> 4, hgl_, kk & 1, sm, tid2, ctr, nxt);
                else if (isdec) gla_item<true, true>(X, l, 1, kk >> 4, hgl_, kk & 1, sm, tid2, ctr, nxt);
                else gla_item<true, false>(X, l, 0, kk >> 4, hgl_, kk & 1, sm, tid2, ctr, nxt); }
            else lru_item(X, l, isdec, kk >> 4, (kk >> 1) & 7, kk & 1, sm, tid2, ctr, nxt);
        }
        if (tid == 0) *(LAS unsigned*)(sm + L_MISC) = nxt;
        __syncthreads();
        it = (int)__builtin_amdgcn_readfirstlane(*(LAS unsigned*)(sm + L_MISC));
    }
}

#define XB_TMO      128
#define XB_XCNT(j)  (256  + 64 * (j))
#define XB_XSUB(j)  (1280 + 64 * (j))
#define XB_XGEN(j)  (2304 + 64 * (j))
#define XB_TOP      3328
#define XB_TOPGEN   3392
#define XCD_BAR_WORDS 3456
#define XB_SPIN_CAP (1u << 18)

__device__ __forceinline__ unsigned xb_ld(unsigned* p)              { return __hip_atomic_load(p, __ATOMIC_RELAXED, __HIP_MEMORY_SCOPE_AGENT); }
__device__ __forceinline__ unsigned xb_add(unsigned* p, unsigned v) { return __hip_atomic_fetch_add(p, v, __ATOMIC_RELAXED, __HIP_MEMORY_SCOPE_AGENT); }
__device__ __forceinline__ unsigned xb_xcc_id() { return (unsigned)__builtin_amdgcn_s_getreg((3 << 11) | 20) & 0xFu; }
#define XB_SPIN(cond, bar) do { unsigned _sp = 0; while (cond) { __builtin_amdgcn_s_sleep(1); \
    if ((++_sp & 255u) == 0u) { if (xb_ld(&(bar)[XB_TMO])) break; if (_sp > XB_SPIN_CAP) { atomicAdd(&(bar)[XB_TMO], 1u); break; } } } } while (0)

struct XcdBarrier {
    unsigned* bar; unsigned x;
    volatile LAS unsigned* st;
};

__device__ __forceinline__ XcdBarrier xcd_barrier_post(unsigned* bar, volatile LAS unsigned* st) {
    XcdBarrier b; b.bar = bar; b.x = xb_xcc_id(); b.st = st;
    if (threadIdx.x == 0) (void)xb_add(&bar[XB_XCNT(b.x)], 1u);
    return b;
}
__device__ __forceinline__ void xcd_barrier_complete(unsigned* bar, unsigned x, unsigned& nloc, unsigned& nx) {
    const unsigned G = gridDim.x * gridDim.y * gridDim.z;
    unsigned sum, cnt, mine, sp = 0u;
    for (;;) {
        sum = 0u; cnt = 0u; mine = 0u;
#pragma unroll
        for (unsigned j = 0; j < 16; ++j) { const unsigned c = xb_ld(&bar[XB_XCNT(j)]); sum += c; cnt += (c > 0u) ? 1u : 0u; mine = (j == x) ? c : mine; }
        if (sum == G) break;
        __builtin_amdgcn_s_sleep(1);
        if ((++sp & 255u) == 0u) { if (xb_ld(&bar[XB_TMO])) break; if (sp > XB_SPIN_CAP) { atomicAdd(&bar[XB_TMO], 1u); break; } }
    }
    nloc = mine > 0u ? mine : 1u; nx = cnt > 0u ? cnt : 1u;
}

__device__ __forceinline__ void xcd_barrier(const XcdBarrier& b) {
    asm volatile("s_waitcnt vmcnt(0)" ::: "memory");
    __syncthreads();
    if (threadIdx.x == 0) {
        unsigned* bar = b.bar;
        __builtin_amdgcn_s_waitcnt(0);
        unsigned nloc = b.st[0], nx = b.st[1];
        if (nloc == 0u) { xcd_barrier_complete(bar, b.x, nloc, nx); b.st[0] = nloc; b.st[1] = nx; }
        const unsigned old = xb_add(&bar[XB_XSUB(b.x)], 1u);
        const unsigned gen = old / nloc;
        if (old + 1u == (gen + 1u) * nloc) {
            __builtin_amdgcn_fence(__ATOMIC_RELEASE, "agent");
            asm volatile("s_waitcnt vmcnt(0)" ::: "memory");
            const unsigned og = xb_add(&bar[XB_TOP], 1u);
            const unsigned tg = og / nx;
            if (og + 1u == (tg + 1u) * nx) xb_add(&bar[XB_TOPGEN], 1u);
            else XB_SPIN(xb_ld(&bar[XB_TOPGEN]) == tg, bar);
            __builtin_amdgcn_fence(__ATOMIC_ACQUIRE, "agent");
            xb_add(&bar[XB_XGEN(b.x)], 1u);
            asm volatile("s_waitcnt vmcnt(0)" ::: "memory");
        } else {
            XB_SPIN(xb_ld(&bar[XB_XGEN(b.x)]) == gen, bar);
            __builtin_amdgcn_fence(__ATOMIC_ACQUIRE, "agent");
            asm volatile("s_waitcnt vmcnt(0)" ::: "memory");
        }
    }
    __syncthreads();
}

template <class T> __device__ __forceinline__ T* as_global(T* q) {
#if defined(__HIP_DEVICE_COMPILE__)
    return (T*)(__attribute__((address_space(1))) T*)q;
#else
    return q;
#endif
}
__device__ __forceinline__ const void* kernarg_ptr() {
#if defined(__HIP_DEVICE_COMPILE__)
    return (const void*)__builtin_amdgcn_kernarg_segment_ptr();
#else
    return nullptr;
#endif
}
__device__ __forceinline__ int kernarg_int(int off) {
#if defined(__HIP_DEVICE_COMPILE__)
    return *(const __attribute__((address_space(4))) int*)((const __attribute__((address_space(4))) char*)__builtin_amdgcn_kernarg_segment_ptr() + off);
#else
    return 0;
#endif
}
__device__ __forceinline__ Ctx make_ctx() {
#if defined(__HIP_DEVICE_COMPILE__)
    const __attribute__((address_space(4))) ParamsG* kp_ = (const __attribute__((address_space(4))) ParamsG*)__builtin_amdgcn_kernarg_segment_ptr(); asm volatile("" : "+s"(kp_));
    const __attribute__((address_space(4))) ParamsG& p = *kp_;
#else
    const ParamsG pp_{}; const ParamsG& p = pp_;
#endif
    Ctx X;
    X.x_prompt = (const float*)p.in[0]; X.x_sample = (const float*)p.in[1]; X.state_lru = (const float*)p.in[2]; X.state_hgrn = (const float*)p.in[3]; X.state_ret = (const float*)p.in[4]; X.c = (const float*)p.in[5]; X.c_ctx = (const float*)p.in[6]; X.norm_g = (const float*)p.in[7];
    X.w_mod = (const float*)p.in[8]; X.b_mod = (const float*)p.in[9]; X.w_in = (const float*)p.in[10]; X.conv_w = (const float*)p.in[11]; X.conv_b = (const float*)p.in[12]; X.lru_wa = (const float*)p.in[13]; X.lru_ba = (const float*)p.in[14]; X.lru_wx = (const float*)p.in[15];
    X.lru_bx = (const float*)p.in[16]; X.lru_lambda = (const float*)p.in[17]; X.hgrn_lb_logits = (const float*)p.in[18]; X.hgrn_norm_g = (const float*)p.in[19]; X.ret_decay_logit = (const float*)p.in[20]; X.ret_norm_g = (const float*)p.in[21];
    X.w_out = (const float*)p.in[22]; X.final_g = (const float*)p.in[23]; X.out = (float*)p.out; unsigned char* ws_ = (unsigned char*)p.ws;
    X.ctl = (unsigned*)(ws_ + WS_CTL); X.MOD = (float*)(ws_ + WS_MOD); X.ROPE = (float*)(ws_ + WS_ROPE);
    X.WIN = (bf16_t*)(ws_ + WS_WIN); X.WOUT = (bf16_t*)(ws_ + WS_WOUT); X.PROJ = (bf16_t*)(ws_ + WS_PROJ); X.OF = (bf16_t*)(ws_ + WS_OF); X.OB = (bf16_t*)(ws_ + WS_OB); X.XN = (bf16_t*)(ws_ + WS_XN);

    return X;
}

constexpr int CW_BAR = 1024;
constexpr int L_BARST = 140016;
__device__ __forceinline__ void mk_barrier(LAS unsigned char* sm) {
    const Ctx X = make_ctx();
    XcdBarrier b; b.bar = X.ctl + CW_BAR; b.x = xb_xcc_id(); b.st = (volatile LAS unsigned*)(sm + L_BARST);
    xcd_barrier(b);
}

constexpr int CW_XLOC = 4608;
constexpr int CW_XLB = 5632;
constexpr int CW_POSTDONE = 6720;
constexpr int L_XID = L_BARST + 16;
__device__ __forceinline__ void xl_barrier(unsigned* ctl, LAS unsigned char* sm, const int tid, const unsigned* extra = nullptr, const unsigned extra_target = 0u) {
    asm volatile("s_waitcnt vmcnt(0)" ::: "memory");
    __syncthreads();
    if (tid == 0) {
        unsigned* c = ctl + CW_XLB + 64 * *(LAS unsigned*)(sm + L_XID);
        const unsigned old = __hip_atomic_fetch_add(c, 1u, __ATOMIC_RELAXED, __HIP_MEMORY_SCOPE_AGENT);
        const unsigned target = (old / 32u + 1u) * 32u; unsigned sp = 0;
        for (;;) {
            const unsigned e = extra ? __hip_atomic_load(extra, __ATOMIC_RELAXED, __HIP_MEMORY_SCOPE_AGENT) : extra_target;
            const unsigned v = __hip_atomic_load(c, __ATOMIC_RELAXED, __HIP_MEMORY_SCOPE_AGENT);
            if ((v >= target && e >= extra_target) || ++sp > (1u << 22)) break;
            __builtin_amdgcn_s_sleep(1); }
        __builtin_amdgcn_fence(__ATOMIC_ACQUIRE, "agent"); asm volatile("s_waitcnt vmcnt(0)" ::: "memory");
    }
    __syncthreads();
}
struct OutOrder {
    pg8::StaticOrder so; int fast, pm, pn, has;
    __device__ bool next(int i, pg8::Unit& u) const { if (!fast) return so.next(i, u); if (i > 0 || !has) return false; u.pm = pm; u.pn = pn; return true; }
    __device__ __forceinline__ void a_ready(const pg8::Unit&) const {}
    __device__ __forceinline__ void done(const pg8::Unit&) const {}
};
template <int l> __device__ __forceinline__ void layer_phases(cg::grid_group& grid, LAS unsigned char* sm, const int wave_s) {
#define XCC_ID ((int)__builtin_amdgcn_readfirstlane(*(LAS unsigned*)(sm + L_XID)))
#define XCC_LI ((int)__builtin_amdgcn_readfirstlane(*(LAS unsigned*)(sm + L_XID + 4)))
#define XFAST (__builtin_amdgcn_readfirstlane(*(LAS unsigned*)(sm + L_XID + 8)) != 0u)
#define XBASE (XFAST ? XCC_ID * 1536 + XCC_LI * 48 : -1)
        if constexpr (l != 0) {
            if (!XFAST) {
                { const Ctx X = make_ctx(); phase_xn(X, l, tid_of(wave_s)); }
                mk_barrier(sm);
            }
        }
        {
            const Ctx X = make_ctx(); const int kin = kernarg_int(208);
            pg8::Gemm g{X.XN, X.WIN + (size_t)l * DIN * DM, NTOK, DIN, kin}; InProjOrder S; S.init(NTOK, DIN - 256, (int)gridDim.x, (int)blockIdx.x);
            EpiProjT<-1> E{X.PROJ};
            pg8::gemm_phase<EpiProjT<-1>, InProjOrder, false>(sm, g, S, E, nullptr, tid_of(wave_s));
        }
        mk_barrier(sm);
        { const Ctx X = make_ctx(); phase_mixer(X, l, sm, tid_of(wave_s), kernarg_int(208)); }
        mk_barrier(sm);
        { const Ctx X = make_ctx(); phase_post(X, l, tid_of(wave_s), XBASE); }
        if (XFAST) { const Ctx X = make_ctx(); xl_barrier(X.ctl, sm, tid_of(wave_s));
            if constexpr (l == 0) { if (tid_of(wave_s) == 0) __hip_atomic_fetch_add(X.ctl + CW_POSTDONE, 1u, __ATOMIC_RELAXED, __HIP_MEMORY_SCOPE_AGENT); }
        } else mk_barrier(sm);
        {
            const Ctx X = make_ctx(); const int kout = kernarg_int(212);
            pg8::Gemm g{X.OF, X.WOUT + (size_t)l * DM * DMIX, NTOK, DM, kout};
            OutOrder S; S.so.init(NTOK, DM, (int)gridDim.x, (int)blockIdx.x); { const int xli = XCC_LI; S.fast = XFAST ? 1 : 0; S.has = (S.fast && xli < 24) ? 1 : 0; S.pm = XCC_ID * 6 + (xli >> 2); S.pn = xli & 3; }
            EpiResid E{X.x_prompt, X.x_sample, X.out, X.MOD + (size_t)l * 5 * 3072, l};
            pg8::gemm_phase<EpiResid, OutOrder, false>(sm, g, S, E, nullptr, tid_of(wave_s));
            if constexpr (l == 0) {
                if (XFAST) { const int xli = XCC_LI; l1_weights_idle(X, sm, tid_of(wave_s), (xli >= 24) ? XCC_ID * 8 + (xli - 24) : -1, 64); }
                else if (gridDim.x > 192) l1_weights_idle(X, sm, tid_of(wave_s), (int)blockIdx.x - 192, (int)gridDim.x - 192);
                else l1_weights_idle(X, sm, tid_of(wave_s), (int)blockIdx.x, (int)gridDim.x);
            }
        }
        if (XFAST) {
            { const Ctx X = make_ctx(); if constexpr (l == 0) xl_barrier(X.ctl, sm, tid_of(wave_s), X.ctl + CW_POSTDONE, gridDim.x); else xl_barrier(X.ctl, sm, tid_of(wave_s)); }
            if constexpr (l == 0) {
                { const Ctx X = make_ctx(); phase_xn(X, 1, tid_of(wave_s), XBASE); } mk_barrier(sm); }
            else { const Ctx X = make_ctx(); phase_final(X, tid_of(wave_s), XBASE); }
        } else mk_barrier(sm);
    }
#undef XCC_ID
#undef XCC_LI
#undef XFAST
#undef XBASE
__global__ void __launch_bounds__(512, 2) fwd_megakernel(Params p) {
    extern __shared__ __attribute__((aligned(16))) unsigned char lds[];
    cg::grid_group grid = cg::this_grid();
    LAS unsigned char* sm = (LAS unsigned char*)lds;
    const int wave_s = __builtin_amdgcn_readfirstlane(threadIdx.x >> 6);
    if (threadIdx.x < 2) *(LAS unsigned*)(sm + L_BARST + 4 * threadIdx.x) = 0u;
    if (threadIdx.x == 0) { const Ctx X = make_ctx(); const unsigned x = xb_xcc_id();
        *(LAS unsigned*)(sm + L_XID) = x; *(LAS unsigned*)(sm + L_XID + 4) = __hip_atomic_fetch_add(X.ctl + CW_XLOC + 64 * x, 1u, __ATOMIC_RELAXED, __HIP_MEMORY_SCOPE_AGENT); *(LAS unsigned*)(sm + L_XID + 8) = 0u; }
    __syncthreads();
    { const Ctx X = make_ctx(); (void)xcd_barrier_post(X.ctl + CW_BAR, (volatile LAS unsigned*)(sm + L_BARST)); }
    { const Ctx X = make_ctx(); phase0(X, sm, tid_of(wave_s)); }
    { const Ctx X = make_ctx(); phase_xn(X, 0, tid_of(wave_s)); }
    mk_barrier(sm);
    if (threadIdx.x == 0) {
        const Ctx X = make_ctx(); unsigned ok = 1u, nx = 0u;
        for (int j = 0; j < 16; ++j) { const unsigned c = __hip_atomic_load(X.ctl + CW_XLOC + 64 * j, __ATOMIC_RELAXED, __HIP_MEMORY_SCOPE_AGENT); if (c) { ++nx; if (c != 32u || j >= 8) ok = 0u; } }
        if (nx != 8u || gridDim.x != 256u) ok = 0u;
        *(LAS unsigned*)(sm + L_XID + 8) = ok; }
    __syncthreads();
    layer_phases<0>(grid, sm, wave_s);
    layer_phases<1>(grid, sm, wave_s);
    if (*(LAS unsigned*)(sm + L_XID + 8) == 0u) { const Ctx X = make_ctx(); phase_final(X, tid_of(wave_s)); }
}

extern "C" void kernel_launch(void* const* d_in, const int* in_sizes, int n_in, void* d_out, int out_size, void* d_ws, size_t ws_size, hipStream_t stream) {
    static int grid_blocks = 0;
    if (grid_blocks == 0) {
        int dev = 0, cus = 0, per_cu = 0;
        hipGetDevice(&dev);
        hipDeviceGetAttribute(&cus, hipDeviceAttributeMultiprocessorCount, dev);
        if (hipFuncSetAttribute((const void*)fwd_megakernel, hipFuncAttributeMaxDynamicSharedMemorySize, LDS_BYTES) != hipSuccess) { fprintf(stderr, "hipFuncSetAttribute failed\n"); }
        if (hipOccupancyMaxActiveBlocksPerMultiprocessor(&per_cu, (const void*)fwd_megakernel, 512, LDS_BYTES) != hipSuccess || per_cu < 1) { fprintf(stderr, "occupancy query: %d\n", per_cu); per_cu = 1; }
        (void)hipGetLastError();
        grid_blocks = cus * 1;
        if (ws_size < WS_END) { fprintf(stderr, "workspace too small: %zu\n", ws_size); grid_blocks = -1; }
    }
    if (grid_blocks < 0) return;
    Params p{};
    for (int i = 0; i < 24; ++i) p.in[i] = (const float*)d_in[i];
    p.out = (float*)d_out; p.ws = (unsigned char*)d_ws; p.kin = DM; p.kout = DMIX;
    if (hipMemsetAsync((char*)d_ws + WS_CTL, 0, 64 * 1024, stream) != hipSuccess) { fprintf(stderr, "memset failed\n"); return; }
    void* args[] = {&p};
    hipError_t e = hipLaunchCooperativeKernel((const void*)fwd_megakernel, dim3(grid_blocks), dim3(512), args, LDS_BYTES, stream);
    if (e != hipSuccess) fprintf(stderr, "cooperative launch failed: %s (grid %d)\n", hipGetErrorString(e), grid_blocks);
}
```

```cpp
#include <hip/hip_runtime.h>
#include <hip/hip_cooperative_groups.h>
#include <cstdio>
namespace pg8 {
#define PG8_LAS __attribute__((address_space(3)))
typedef unsigned short bf16_t;
typedef short bf16x8 __attribute__((ext_vector_type(8)));
typedef float f32x4 __attribute__((ext_vector_type(4)));
typedef unsigned u32x4 __attribute__((ext_vector_type(4)));
constexpr int BM = 256, BK = 64, HALF = 128, HTB = HALF * BK * 2  , STAGE_BYTES = 8 * HTB, NXCD = 8, WGM = 6;

__host__ __device__ __forceinline__ int lds_byte(int r, int c) { const int st = (r >> 4) * 2 + (c >> 5), rr = r & 15, cc = c & 31, ob = rr * 64 + cc * 2; return st * 1024 + (ob ^ (((ob >> 9) & 1) << 5)); }
__host__ __device__ __forceinline__ void stage_rc(int b, int& R, int& C) { const int st = b / 1024, sb = b % 1024, swz = sb ^ (((sb >> 9) & 1) << 5); R = (st >> 1) * 16 + swz / 64; C = (st & 1) * 32 + (swz % 64) / 2; }
__host__ __device__ __forceinline__ int perm32(int rho) { const int n = rho >> 4, i = rho & 15; return 8 * (i >> 2) + 4 * n + (i & 3); }

struct Unit { int pm, pn; };
struct Gemm { const bf16_t* A; const bf16_t* Bt; int M, N, K; };

struct StaticOrder {
    int nM, nN, nwg, G, c;
    __host__ __device__ void init(int M, int N, int G_, int c_) { nM = M / BM; nN = N / BM; nwg = nM * nN; G = G_; c = c_; }
    __host__ __device__ bool next(int i, Unit& u) const {
        const long L = (long)i * G + c; if (L >= nwg) return false;
        int wgid = (int)L; { const int q = nwg / NXCD, r = nwg % NXCD, xcd = wgid % NXCD, off = wgid / NXCD; wgid = (xcd < r ? xcd * (q + 1) : r * (q + 1) + (xcd - r) * q) + off; }
        const int nig = WGM * nN, gid = wgid / nig, fm = gid * WGM, gsz = (nM - fm) < WGM ? (nM - fm) : WGM;
        u.pm = fm + ((wgid % nig) % gsz); u.pn = (wgid % nig) / gsz; return true;
    }
    __device__ __forceinline__ void a_ready(const Unit&) const {}
    __device__ __forceinline__ void done(const Unit&) const {}
};
struct CountedOrder : StaticOrder {
    const unsigned* ready; unsigned need; unsigned* tmo;
    __device__ __forceinline__ void a_ready(const Unit& u) const {
        if (threadIdx.x < 64) {
            const unsigned long long t0 = __builtin_amdgcn_s_memrealtime(); unsigned polls = 0;
            while ((unsigned)__builtin_amdgcn_readfirstlane(__hip_atomic_load(ready + 64 * u.pm, __ATOMIC_RELAXED, __HIP_MEMORY_SCOPE_AGENT)) < need) {
                if ((++polls & 255u) == 0u && __builtin_amdgcn_readfirstlane(__hip_atomic_load(tmo, __ATOMIC_RELAXED, __HIP_MEMORY_SCOPE_AGENT)) != 0u) break;
                if (__builtin_amdgcn_s_memrealtime() - t0 > 2000000ull) {
                    if (threadIdx.x == 0) { unsigned expect = 0u; __hip_atomic_compare_exchange_strong(tmo + 1, &expect, 0x600u | (unsigned)(u.pm & 0xff), __ATOMIC_RELAXED, __ATOMIC_RELAXED, __HIP_MEMORY_SCOPE_AGENT); __hip_atomic_store(tmo, 1u, __ATOMIC_RELAXED, __HIP_MEMORY_SCOPE_AGENT); }
                    break; }
                __builtin_amdgcn_s_sleep(2); }
            __builtin_amdgcn_fence(__ATOMIC_ACQUIRE, "agent");
            asm volatile("s_waitcnt vmcnt(0)" ::: "memory");
        }
#if !defined(BROKEN_HOOK_NO_BARRIER)
        asm volatile("" ::: "memory"); __builtin_amdgcn_s_barrier(); asm volatile("" ::: "memory");
#endif
    }
};

typedef float cvtf2_t __attribute__((ext_vector_type(2)));
typedef __bf16 cvtb2_t __attribute__((ext_vector_type(2)));
__device__ __forceinline__ unsigned cvt_pk_bf16(float lo, float hi) { const cvtf2_t v = {lo, hi}; const cvtb2_t r = __builtin_convertvector(v, cvtb2_t); return __builtin_bit_cast(unsigned, r); }
typedef float f32x2 __attribute__((ext_vector_type(2)));
__device__ __forceinline__ f32x2 gelu_pk(f32x2 v) {
    const f32x2 av = __builtin_elementwise_abs(v), d = av * 0.2316418882f + 1.0f;
    f32x2 t; t.x = __builtin_amdgcn_rcpf(d.x); t.y = __builtin_amdgcn_rcpf(d.y);
    f32x2 q = t * 0.5307027145f + (-0.7265760135f); q = q * t + 0.7107068705f; q = q * t + (-0.142248368f); q = q * t + 0.127414796f; q = q * t;
    const f32x2 s = (v * v) * (-0.72134752044f);
    f32x2 e; e.x = __builtin_amdgcn_exp2f(s.x); e.y = __builtin_amdgcn_exp2f(s.y);
    const f32x2 m = v * (q * e), r = v - m;
    f32x2 o; o.x = v.x < 0.f ? m.x : r.x; o.y = v.y < 0.f ? m.y : r.y; return o;
}

struct EpiF32 {
    static constexpr bool PERM = false, AFTER_DRAIN = false;
    float* C; int ldc; const float* bias;
    __device__ __forceinline__ void operator()(const f32x4 (&acc)[2][2][4][2], const Unit& u, int wr, int wc, int fr, int fq) const {
        const int row0 = u.pm * BM + wr * 64 + fr, col0 = u.pn * BM + wc * 32 + 4 * fq;
        f32x4 bv[2][2];
#pragma unroll
        for (int bj = 0; bj < 2; ++bj)
#pragma unroll
            for (int n = 0; n < 2; ++n) bv[bj][n] = bias ? *(const f32x4*)(bias + col0 + bj * HALF + n * 16) : (f32x4){0.f, 0.f, 0.f, 0.f};
#pragma unroll
        for (int ai = 0; ai < 2; ++ai)
#pragma unroll
            for (int m = 0; m < 4; ++m) { float* rowp = C + (size_t)(row0 + ai * HALF + m * 16) * ldc + col0;
#pragma unroll
                for (int bj = 0; bj < 2; ++bj)
#pragma unroll
                    for (int n = 0; n < 2; ++n) *(f32x4*)(rowp + bj * HALF + n * 16) = acc[ai][bj][m][n] + bv[bj][n]; }
    }
};
template <int ACT  > struct EpiBf16 {
    static constexpr bool PERM = true, AFTER_DRAIN = false;
    bf16_t* O; int ldc; const float* bias; int split_cols; size_t split_stride;
    __device__ __forceinline__ void operator()(const f32x4 (&acc)[2][2][4][2], const Unit& u, int wr, int wc, int fr, int fq) const {
        const int row0 = u.pm * BM + wr * 64 + fr; int colt = u.pn * BM; bf16_t* base = O;
        if (split_cols) { const int t = colt / split_cols; base += (size_t)t * split_stride; colt -= t * split_cols; }
        const int col0 = colt + wc * 32 + 8 * fq, bcol0 = u.pn * BM + wc * 32 + 8 * fq;
        f32x4 bv[2][2];
#pragma unroll
        for (int bj = 0; bj < 2; ++bj)
#pragma unroll
            for (int n = 0; n < 2; ++n) bv[bj][n] = bias ? *(const f32x4*)(bias + bcol0 + bj * HALF + 4 * n) : (f32x4){0.f, 0.f, 0.f, 0.f};
#pragma unroll
        for (int ai = 0; ai < 2; ++ai)
#pragma unroll
            for (int m = 0; m < 4; ++m) { bf16_t* rowp = base + (size_t)(row0 + ai * HALF + m * 16) * ldc + col0;
#pragma unroll
                for (int bj = 0; bj < 2; ++bj) { f32x4 v0 = acc[ai][bj][m][0] + bv[bj][0], v1 = acc[ai][bj][m][1] + bv[bj][1];
                    if (ACT == 1) { f32x2 a = gelu_pk((f32x2){v0[0], v0[1]}), b = gelu_pk((f32x2){v0[2], v0[3]}), c = gelu_pk((f32x2){v1[0], v1[1]}), d = gelu_pk((f32x2){v1[2], v1[3]});
                        v0 = (f32x4){a.x, a.y, b.x, b.y}; v1 = (f32x4){c.x, c.y, d.x, d.y}; }
                    if (ACT == 2) {
#pragma unroll
                        for (int j = 0; j < 4; ++j) { v0[j] = 0.5f * v0[j] * (1.0f + erff(v0[j] * 0.70710678f)); v1[j] = 0.5f * v1[j] * (1.0f + erff(v1[j] * 0.70710678f)); } }
                    u32x4 w; w.x = cvt_pk_bf16(v0[0], v0[1]); w.y = cvt_pk_bf16(v0[2], v0[3]); w.z = cvt_pk_bf16(v1[0], v1[1]); w.w = cvt_pk_bf16(v1[2], v1[3]);
                    *(u32x4*)(rowp + bj * HALF) = w; } }
    }
};
template <class Epi, class Sched, bool STAMP = false>
__device__ __forceinline__ void gemm_phase(PG8_LAS unsigned char* lds, const Gemm g, const Sched& S, const Epi& E, unsigned long long* stamps, const int tid_in) {
    int tid_ = tid_in; asm volatile("" : "+v"(tid_));
    const int tid = tid_, wid = __builtin_amdgcn_readfirstlane(tid >> 6), lane = tid & 63, wr = wid >> 2, wc = wid & 3, fr = lane & 15, fq = lane >> 4;
    const int K = g.K, nt = K / BK;
    int ts_lo = 0, ts_hi = 0, nts = 0; const unsigned long long rt_entry = STAMP ? (unsigned long long)wall_clock64() : 0ull;
#define PG8_STAMP() do { if (STAMP && wid == 0 && nts < 64) { const unsigned long long _c = (unsigned long long)clock64(); \
        ts_lo = (lane == nts) ? (int)(unsigned)_c : ts_lo; ts_hi = (lane == nts) ? (int)(unsigned)(_c >> 32) : ts_hi; ++nts; } } while (0)
    PG8_STAMP();
    unsigned voffA[2], voffB[2];
#pragma unroll
    for (int i = 0; i < 2; ++i) { int R, C; stage_rc(tid * 16 + i * 8192, R, C); const int Rb = Epi::PERM ? ((R & ~31) + perm32(R & 31)) : R;
        voffA[i] = (unsigned)(R * K + C) * 2u; voffB[i] = (unsigned)(Rb * K + C) * 2u; }
    const size_t kstep = (size_t)(BK * 2);
    const size_t hstep = (size_t)HALF * K * 2;
    const size_t tstep = 2 * hstep;
    const unsigned ldsw = (unsigned)wid * 1024u;
    const int aoff = lds_byte(wr * 64 + fr, fq * 8), boff = lds_byte(wc * 32 + fr, fq * 8);
#define PG8_SA(b, h) (((b) * 2 + (h)) * HTB)
#define PG8_SB(b, h) ((4 + (b) * 2 + (h)) * HTB)
#define PG8_STAGE(bufoff, gbase, voff) do { _Pragma("unroll") for (int _i = 0; _i < 2; ++_i) \
        __builtin_amdgcn_global_load_lds((const unsigned*)((const char*)(gbase) + (voff)[_i]), (PG8_LAS unsigned*)(lds + (bufoff) + ldsw + _i * 8192), 16, 0, 0); } while (0)
#define PG8_LDA(dst, b, h) do { _Pragma("unroll") for (int m = 0; m < 4; ++m) _Pragma("unroll") for (int k = 0; k < 2; ++k) dst[m][k] = *(const PG8_LAS bf16x8*)(lds + PG8_SA(b, h) + aoff + m * 2048 + k * 1024); } while (0)
#define PG8_LDB(dst, b, h) do { _Pragma("unroll") for (int n = 0; n < 2; ++n) _Pragma("unroll") for (int k = 0; k < 2; ++k) dst[n][k] = *(const PG8_LAS bf16x8*)(lds + PG8_SB(b, h) + boff + n * 2048 + k * 1024); } while (0)
#define PG8_MMA(ai, bj, At, Bt) do { __builtin_amdgcn_s_setprio(1); _Pragma("unroll") for (int m = 0; m < 4; ++m) _Pragma("unroll") for (int n = 0; n < 2; ++n) _Pragma("unroll") for (int k = 0; k < 2; ++k) \
        acc[ai][bj][m][n] = __builtin_amdgcn_mfma_f32_16x16x32_bf16(Bt[n][k], At[m][k], acc[ai][bj][m][n], 0, 0, 0); __builtin_amdgcn_s_setprio(0); } while (0)
#define PG8_WAIT_V(n) asm volatile("s_waitcnt vmcnt(" #n ")" ::: "memory")
#define PG8_WAIT_L(n) asm volatile("s_waitcnt lgkmcnt(" #n ")" ::: "memory")
#define PG8_BAR __builtin_amdgcn_s_barrier()
#define PG8_SCHED __builtin_amdgcn_sched_barrier(0)
    Unit cur, nxt; int ui = 0;
    if (!S.next(0, cur)) return;
    f32x4 acc[2][2][4][2];
#pragma unroll
    for (int a = 0; a < 2; ++a)
#pragma unroll
        for (int b = 0; b < 2; ++b)
#pragma unroll
            for (int m = 0; m < 4; ++m)
#pragma unroll
                for (int n = 0; n < 2; ++n) acc[a][b][m][n] = (f32x4){0.f, 0.f, 0.f, 0.f};
    bf16x8 At[4][2], B0[2][2], B1[2][2];
    const char* cA = (const char*)g.A + (size_t)cur.pm * tstep; const char* cB = (const char*)g.Bt + (size_t)cur.pn * tstep;
    S.a_ready(cur);
    PG8_STAGE(PG8_SB(0, 0), cB, voffB); PG8_STAGE(PG8_SA(0, 0), cA, voffA); PG8_STAGE(PG8_SB(0, 1), cB + hstep, voffB); PG8_STAGE(PG8_SA(0, 1), cA + hstep, voffA);
    if (wr == 1) PG8_BAR;
    PG8_WAIT_V(4); PG8_BAR;
    PG8_STAGE(PG8_SB(1, 0), cB + kstep, voffB); PG8_STAGE(PG8_SA(1, 0), cA + kstep, voffA); PG8_STAGE(PG8_SB(1, 1), cB + hstep + kstep, voffB);
    PG8_WAIT_V(6); PG8_BAR;
    PG8_STAMP();
    for (;;) {
        const bool has_next = S.next(ui + 1, nxt);
        const char* nA = has_next ? (const char*)g.A + (size_t)nxt.pm * tstep : cA; const char* nB = has_next ? (const char*)g.Bt + (size_t)nxt.pn * tstep : cB;
        for (int t = 0; t < nt; t += 2) {
            const bool last = (t == nt - 2);
            const char* a1 = cA + (size_t)(t + 1) * kstep;
            const char* a2 = last ? nA : cA + (size_t)(t + 2) * kstep; const char* b2 = last ? nB : cB + (size_t)(t + 2) * kstep;
            const char* a3 = a2 + kstep; const char* b3 = b2 + kstep;
            if (last && has_next) S.a_ready(nxt);
            PG8_LDB(B0, 0, 0); PG8_SCHED; PG8_LDA(At, 0, 0); PG8_STAGE(PG8_SA(1, 1), a1 + hstep, voffA);
            PG8_WAIT_L(8); PG8_BAR; PG8_WAIT_L(0); PG8_MMA(0, 0, At, B0); PG8_BAR; PG8_SCHED;
            PG8_LDB(B1, 0, 1); PG8_STAGE(PG8_SB(0, 0), b2, voffB);
            PG8_BAR; PG8_WAIT_L(0); PG8_MMA(0, 1, At, B1); PG8_BAR;
            PG8_LDA(At, 0, 1); PG8_STAGE(PG8_SA(0, 0), a2, voffA);
            PG8_BAR; PG8_WAIT_L(0); PG8_MMA(1, 0, At, B0); PG8_BAR; PG8_SCHED;
            PG8_STAGE(PG8_SB(0, 1), b2 + hstep, voffB);
            PG8_WAIT_V(6); PG8_BAR; PG8_MMA(1, 1, At, B1); PG8_BAR;
            PG8_LDB(B0, 1, 0); PG8_SCHED; PG8_LDA(At, 1, 0); PG8_STAGE(PG8_SA(0, 1), a2 + hstep, voffA);
            PG8_WAIT_L(8); PG8_BAR; PG8_WAIT_L(0); PG8_MMA(0, 0, At, B0); PG8_BAR; PG8_SCHED;
            PG8_LDB(B1, 1, 1); PG8_STAGE(PG8_SB(1, 0), b3, voffB);
            PG8_BAR; PG8_WAIT_L(0); PG8_MMA(0, 1, At, B1); PG8_BAR;
            PG8_LDA(At, 1, 1); PG8_STAGE(PG8_SA(1, 0), a3, voffA);
            PG8_BAR; PG8_WAIT_L(0); PG8_MMA(1, 0, At, B0); PG8_BAR; PG8_SCHED;
            PG8_STAGE(PG8_SB(1, 1), b3 + hstep, voffB);
            PG8_WAIT_V(6); PG8_BAR; PG8_MMA(1, 1, At, B1); PG8_BAR;
        }
        PG8_STAMP();
        if constexpr (!Epi::AFTER_DRAIN) { E(acc, cur, wr, wc, fr, fq); S.done(cur); }
        PG8_STAMP();
        if (!has_next) break;
#pragma unroll
        for (int a = 0; a < 2; ++a)
#pragma unroll
            for (int b = 0; b < 2; ++b)
#pragma unroll
                for (int m = 0; m < 4; ++m)
#pragma unroll
                    for (int n = 0; n < 2; ++n) acc[a][b][m][n] = (f32x4){0.f, 0.f, 0.f, 0.f};
        cur = nxt; cA = nA; cB = nB; ++ui;
    }
    PG8_WAIT_V(0);
    if (wr == 0) PG8_BAR;
    PG8_BAR;
    if constexpr (Epi::AFTER_DRAIN) { E.fused(acc, cur, wr, wc, fr, fq, lds, wid, lane); S.done(cur); }
    PG8_STAMP();
    if (STAMP && wid == 0) { stamps[lane] = lane < nts ? (((unsigned long long)(unsigned)ts_hi << 32) | (unsigned)ts_lo) : 0ull;
        if (lane == 62) stamps[62] = rt_entry; if (lane == 63) stamps[63] = (unsigned long long)wall_clock64(); }
#undef PG8_STAMP
#undef PG8_SA
#undef PG8_SB
#undef PG8_STAGE
#undef PG8_LDA
#undef PG8_LDB
#undef PG8_MMA
#undef PG8_WAIT_V
#undef PG8_WAIT_L
#undef PG8_BAR
#undef PG8_SCHED
}
}

namespace cg = cooperative_groups;
#define LAS __attribute__((address_space(3)))
typedef unsigned short bf16_t;
typedef short bf16x8 __attribute__((ext_vector_type(8)));
typedef float f32x4 __attribute__((ext_vector_type(4)));
typedef unsigned u32x4 __attribute__((ext_vector_type(4)));
typedef unsigned u32x2 __attribute__((ext_vector_type(2)));

constexpr int DM = 1024, NTOK = 12288, NCTX = 8192, DIN = 5632, DMIX = 1536;
constexpr int LDS_BYTES = 147456;
constexpr size_t MiB = 1u << 20;
constexpr size_t WS_CTL = 0;
constexpr size_t WS_MOD = 64 * 1024;
constexpr size_t WS_ROPE = 256 * 1024;
constexpr size_t WS_WIN = 1 * MiB;
constexpr size_t WS_WOUT = 23 * MiB;
constexpr size_t WS_PROJ = 29 * MiB;
constexpr size_t WS_OF = 161 * MiB;
constexpr size_t WS_XN = 197 * MiB;
constexpr size_t WS_OB = 213 * MiB;
constexpr size_t WS_END = 249 * MiB;

struct Params { const float* in[24]; float* out; unsigned char* ws; int kin, kout; };
#if defined(__HIP_DEVICE_COMPILE__)
#define GAS1 __attribute__((address_space(1)))
#else
#define GAS1
#endif
struct ParamsG { const GAS1 float* in[24]; GAS1 float* out; GAS1 unsigned char* ws; int kin, kout; };

struct Ctx {
    const float *x_prompt, *x_sample, *state_lru, *state_hgrn, *state_ret, *c, *c_ctx, *norm_g, *w_mod, *b_mod, *w_in, *conv_w, *conv_b,
        *lru_wa, *lru_ba, *lru_wx, *lru_bx, *lru_lambda, *hgrn_lb_logits, *hgrn_norm_g, *ret_decay_logit, *ret_norm_g, *w_out, *final_g;
    float* out; unsigned* ctl; float* MOD; float* ROPE; bf16_t *WIN, *WOUT, *PROJ, *OF, *OB, *XN;
};

__device__ __forceinline__ float bf2f(bf16_t b) { return __uint_as_float(((unsigned)b) << 16); }
typedef float cvt_f2 __attribute__((ext_vector_type(2)));
typedef __bf16 cvt_b2 __attribute__((ext_vector_type(2)));
__device__ __forceinline__ unsigned pk2(float lo, float hi) { const cvt_f2 v = {lo, hi}; const cvt_b2 r = __builtin_convertvector(v, cvt_b2); return __builtin_bit_cast(unsigned, r); }
__device__ __forceinline__ unsigned f2bf(float f) { return pk2(f, f) & 0xffffu; }
__device__ __forceinline__ float frcp(float x) { return __builtin_amdgcn_rcpf(x); }
__device__ __forceinline__ int launder_v(int v) { asm volatile("" : "+v"(v)); return v; }
__device__ __forceinline__ int tid_of(int wave_s) { int z = 0; asm volatile("" : "+v"(z));
    return launder_v(wave_s * 64 + (int)__builtin_amdgcn_mbcnt_hi(~0u, __builtin_amdgcn_mbcnt_lo(~0u, (unsigned)z))); }
__device__ __forceinline__ float wave_sum(float v) {
#pragma unroll
    for (int o = 1; o < 64; o <<= 1) v += __shfl_xor(v, o);
    return v;
}
__device__ __forceinline__ float silu_f(float x) { return x * frcp(1.f + __expf(-x)); }
__device__ __forceinline__ float sigm_f(float x) { return frcp(1.f + __expf(-x)); }

__device__ __forceinline__ void p0_transpose_item(const float* W, int K, int N, bf16_t* WT, LAS float* scr, int item, int lane) {
    const int nblk = N / 32, kb = item / nblk, nb = item % nblk, k0 = 64 * kb, n0 = 32 * nb;
    float tv[32];
#pragma unroll
    for (int i = 0; i < 32; ++i) { const int kk = 2 * i + (lane >> 5); tv[i] = W[(size_t)(k0 + kk) * N + n0 + (lane & 31)]; }
#pragma unroll
    for (int i = 0; i < 32; ++i) { const int kk = 2 * i + (lane >> 5); scr[kk * 33 + (lane & 31)] = tv[i]; }
    asm volatile("s_waitcnt lgkmcnt(0)" ::: "memory");
    const int c = lane & 7;
#pragma unroll
    for (int j = 0; j < 4; ++j) { const int n = (lane >> 3) + 8 * j; const LAS float* s = scr + (8 * c) * 33 + n;
        u32x4 o; o.x = pk2(s[0 * 33], s[1 * 33]); o.y = pk2(s[2 * 33], s[3 * 33]); o.z = pk2(s[4 * 33], s[5 * 33]); o.w = pk2(s[6 * 33], s[7 * 33]);
        *(u32x4*)(WT + (size_t)(n0 + n) * K + k0 + 8 * c) = o; }
    asm volatile("s_waitcnt lgkmcnt(0)" ::: "memory");
}

constexpr int CW_MODCNT = 256;
__device__ __forceinline__ void phase0(const Ctx& X, LAS unsigned char* sm, int tid) {
    const int lane = tid & 63, wave = tid >> 6;
    const bool split = gridDim.x > 96;
    LAS float* sc = (LAS float*)(sm + 69632);
    LAS float* red = (LAS float*)(sm + 90112);
    for (int unit = blockIdx.x; unit < 96; unit += gridDim.x) {
        const int l = unit / 48, jb = unit % 48;
        __syncthreads();
        for (int idx = tid; idx < 5 * 1024; idx += 512) { const int c = idx >> 10, k = idx & 1023; const float v = (c == 0) ? X.c_ctx[k] : X.c[(c - 1) * 1024 + k]; sc[idx] = silu_f(v); }
        __syncthreads();
        const int col = jb * 64 + lane; float a0 = 0.f, a1 = 0.f, a2 = 0.f, a3 = 0.f, a4 = 0.f;
        const float* wp = X.w_mod + ((size_t)l * 1024 + wave * 128) * 3072 + col;
#pragma unroll 16
        for (int kk = 0; kk < 128; ++kk) { const float wv = wp[(size_t)kk * 3072]; const int k = wave * 128 + kk;
            a0 += sc[k] * wv; a1 += sc[1024 + k] * wv; a2 += sc[2048 + k] * wv; a3 += sc[3072 + k] * wv; a4 += sc[4096 + k] * wv; }
        red[(wave * 5 + 0) * 64 + lane] = a0; red[(wave * 5 + 1) * 64 + lane] = a1; red[(wave * 5 + 2) * 64 + lane] = a2; red[(wave * 5 + 3) * 64 + lane] = a3; red[(wave * 5 + 4) * 64 + lane] = a4;
        __syncthreads();
        if (tid < 320) { const int c = tid >> 6, ln = tid & 63; float s = 0.f;
#pragma unroll
            for (int g = 0; g < 8; ++g) s += red[(g * 5 + c) * 64 + ln];
            X.MOD[(size_t)(l * 5 + c) * 3072 + jb * 64 + ln] = s + X.b_mod[l * 3072 + jb * 64 + ln]; }
        asm volatile("s_waitcnt vmcnt(0)" ::: "memory");
        __syncthreads();
        if (tid == 0) { __builtin_amdgcn_fence(__ATOMIC_RELEASE, "agent"); asm volatile("s_waitcnt vmcnt(0)" ::: "memory");
            __hip_atomic_fetch_add(X.ctl + CW_MODCNT, 1u, __ATOMIC_RELAXED, __HIP_MEMORY_SCOPE_AGENT); }
    }
    {
        const int first = split ? 96 : 0;
        if ((int)blockIdx.x >= first) {
            const int gw = ((int)blockIdx.x - first) * 8 + wave, NGW = ((int)gridDim.x - first) * 8;
            LAS float* scr = (LAS float*)(sm + wave * 8448);
            constexpr int I_IN = 16 * 176, I_OUT = 24 * 32, NIT = I_IN + I_OUT;
            for (int it = gw; it < NIT; it += NGW) {
                int r = it;
                if (r < I_IN) p0_transpose_item(X.w_in, 1024, 5632, X.WIN, scr, r, lane);
                else { r -= I_IN; p0_transpose_item(X.w_out, 1536, 1024, X.WOUT, scr, r, lane); }
            }
        }
    }
    if (blockIdx.x == gridDim.x - 1) {
        for (int idx = tid; idx < 2048; idx += 512) { const int pos = idx >> 5, fi = idx & 31;
            const float freq = exp2f(-(float)fi * (13.287712379549449f / 32.0f));
            const float ang = (float)pos * freq; const float rev = ang * 0.15915494309189535f; const float fr = rev - floorf(rev);
            X.ROPE[2 * idx] = __builtin_amdgcn_cosf(fr); X.ROPE[2 * idx + 1] = __builtin_amdgcn_sinf(fr); }
    }
    __syncthreads();
    if (tid == 0) { unsigned sp = 0;
        while (__hip_atomic_load(X.ctl + CW_MODCNT, __ATOMIC_RELAXED, __HIP_MEMORY_SCOPE_AGENT) < 96u) { __builtin_amdgcn_s_sleep(2); if (++sp > (1u << 22)) break; }
        __builtin_amdgcn_fence(__ATOMIC_ACQUIRE, "agent"); asm volatile("s_waitcnt vmcnt(0)" ::: "memory"); }
    __syncthreads();
}
__device__ __forceinline__ void l1_weights_idle(const Ctx& X, LAS unsigned char* sm, int tid, int idle_idx, int nidle) {
    const int lane = tid & 63, wave = tid >> 6;
    if (nidle <= 0 || idle_idx < 0) return;
    const int gw = idle_idx * 8 + wave, NGW = nidle * 8;
    LAS float* scr = (LAS float*)(sm + wave * 8448);
    constexpr int I_IN = 16 * 176, I_OUT = 24 * 32, NIT = I_IN + I_OUT;
    for (int it = gw; it < NIT; it += NGW) {
        int r = it;
        if (r < I_IN) p0_transpose_item(X.w_in + (size_t)1024 * 5632, 1024, 5632, X.WIN + (size_t)5632 * 1024, scr, r, lane);
        else { r -= I_IN; p0_transpose_item(X.w_out + (size_t)1536 * 1024, 1536, 1024, X.WOUT + (size_t)1024 * 1536, scr, r, lane); }
    }
}
__device__ __forceinline__ void phase_xn(const Ctx& X, int l, int tid, int xbase = -1) {
    const int lane = tid & 63, wave = tid >> 6;
    const int gw = blockIdx.x * 8 + wave, NGW = gridDim.x * 8;
    for (int k = 0;; ++k) {
        const int row = (xbase >= 0) ? xbase + wave * 6 + k : gw + k * NGW;
        if ((xbase >= 0) ? (k >= 6) : (row >= NTOK)) break;
        const float* xr = (l == 0) ? ((row < NCTX) ? X.x_prompt + (size_t)row * DM : X.x_sample + (size_t)(row - NCTX) * DM) : X.out + (size_t)row * DM;
        const int c = (row < NCTX) ? 0 : 1 + ((row - NCTX) >> 10);
        const float* md = X.MOD + (size_t)(l * 5 + c) * 3072;
        f32x4 v[4]; float s = 0.f;
#pragma unroll
        for (int j = 0; j < 4; ++j) { v[j] = ((const f32x4*)xr)[lane + 64 * j]; s += (v[j].x * v[j].x + v[j].y * v[j].y) + (v[j].z * v[j].z + v[j].w * v[j].w); }
        f32x4 pg[4], psh[4], pscl[4];
#pragma unroll
        for (int j = 0; j < 4; ++j) { const int k0 = (lane + 64 * j) * 4; pg[j] = *(const f32x4*)(X.norm_g + l * 1024 + k0); psh[j] = *(const f32x4*)(md + k0); pscl[j] = *(const f32x4*)(md + 1024 + k0); }
        const float r = rsqrtf(wave_sum(s) * (1.f / 1024.f) + 1e-6f);
#pragma unroll
        for (int j = 0; j < 4; ++j) { const int k0 = (lane + 64 * j) * 4;
            const f32x4 g = pg[j], sh = psh[j], scl = pscl[j];
            const f32x4 y = v[j] * r * g * (scl + 1.0f) + sh;
            u32x2 o; o.x = pk2(y.x, y.y); o.y = pk2(y.z, y.w);
            *(u32x2*)(X.XN + (size_t)row * DM + k0) = o; }
    }
}

__device__ __forceinline__ void unpack8(const u32x4 p, float (&f)[8]) {
    f[0] = __uint_as_float(p.x << 16); f[1] = __uint_as_float(p.x & 0xffff0000u); f[2] = __uint_as_float(p.y << 16); f[3] = __uint_as_float(p.y & 0xffff0000u);
    f[4] = __uint_as_float(p.z << 16); f[5] = __uint_as_float(p.z & 0xffff0000u); f[6] = __uint_as_float(p.w << 16); f[7] = __uint_as_float(p.w & 0xffff0000u);
}
__device__ __forceinline__ void phase_post(const Ctx& X, int l, int tid, int xbase = -1) {
    const int lane = tid & 63, wave = tid >> 6;
    const int gw = blockIdx.x * 8 + wave, NGW = gridDim.x * 8;
    for (int k = 0;; ++k) {
        const int row = (xbase >= 0) ? xbase + wave * 6 + k : gw + k * NGW;
        if ((xbase >= 0) ? (k >= 6) : (row >= NTOK)) break;
        bf16_t* of = X.OF + (size_t)row * DMIX; const bf16_t* ob = X.OB + (size_t)row * DMIX; const bf16_t* pr = X.PROJ + (size_t)row * DIN;
        const int ch0 = lane * 8;
        u32x4 la[3], lb2[3], lg[3];
#pragma unroll
        for (int pass = 0; pass < 3; ++pass) { const int gcol = (pass == 0) ? 512 : (pass == 1) ? 3072 : 5120;
            la[pass] = *(const u32x4*)(of + pass * 512 + ch0); lb2[pass] = *(const u32x4*)(ob + pass * 512 + ch0); lg[pass] = *(const u32x4*)(pr + gcol + ch0); }
#pragma unroll
        for (int pass = 0; pass < 3; ++pass) {
            float a[8], b[8], g[8], y[8];
            unpack8(la[pass], a); unpack8(lb2[pass], b); unpack8(lg[pass], g);
            float ss = 0.f;
#pragma unroll
            for (int j = 0; j < 8; ++j) { y[j] = a[j] + b[j]; ss += y[j] * y[j]; }
            if (pass > 0) {
                ss += __shfl_xor(ss, 1); ss += __shfl_xor(ss, 2); ss += __shfl_xor(ss, 4); ss += __shfl_xor(ss, 8);
                const float rn = rsqrtf(ss * (1.f / 128.f) + 1e-6f);
                const float* ng = ((pass == 1) ? X.hgrn_norm_g : X.ret_norm_g) + l * 512 + ch0;
                const f32x4 g0 = *(const f32x4*)ng, g1 = *(const f32x4*)(ng + 4);
                y[0] *= rn * g0.x; y[1] *= rn * g0.y; y[2] *= rn * g0.z; y[3] *= rn * g0.w; y[4] *= rn * g1.x; y[5] *= rn * g1.y; y[6] *= rn * g1.z; y[7] *= rn * g1.w;
            }
#pragma unroll
            for (int j = 0; j < 8; ++j) y[j] *= (pass == 2 && ch0 >= 256 && row < NCTX) ? silu_f(g[j]) : g[j];
            u32x4 o; o.x = pk2(y[0], y[1]); o.y = pk2(y[2], y[3]); o.z = pk2(y[4], y[5]); o.w = pk2(y[6], y[7]);
            *(u32x4*)(of + pass * 512 + ch0) = o;
        }
    }
}

__device__ __forceinline__ void phase_final(const Ctx& X, int tid, int xbase = -1) {
    const int lane = tid & 63, wave = tid >> 6;
    const int gw = blockIdx.x * 8 + wave, NGW = gridDim.x * 8;
    for (int k = 0;; ++k) {
        const int row = (xbase >= 0) ? xbase + wave * 6 + k : gw + k * NGW;
        if ((xbase >= 0) ? (k >= 6) : (row >= NTOK)) break;
        float* xr = X.out + (size_t)row * DM;
        f32x4 v[4]; float s = 0.f;
#pragma unroll
        for (int j = 0; j < 4; ++j) { v[j] = ((const f32x4*)xr)[lane + 64 * j]; s += (v[j].x * v[j].x + v[j].y * v[j].y) + (v[j].z * v[j].z + v[j].w * v[j].w); }
        f32x4 fg[4];
#pragma unroll
        for (int j = 0; j < 4; ++j) fg[j] = *(const f32x4*)(X.final_g + (lane + 64 * j) * 4);
        const float r = rsqrtf(wave_sum(s) * (1.f / 1024.f) + 1e-6f);
#pragma unroll
        for (int j = 0; j < 4; ++j) ((f32x4*)xr)[lane + 64 * j] = v[j] * r * fg[j];
    }
}

struct EpiResid {
    static constexpr bool PERM = false, AFTER_DRAIN = false;
    const float* xp; const float* xs; float* out; const float* modl; int layer;
    __device__ __forceinline__ void operator()(const pg8::f32x4 (&acc)[2][2][4][2], const pg8::Unit& u, int wr, int wc, int fr, int fq) const {
        const int row0 = u.pm * 256 + wr * 64 + fr, col0 = u.pn * 256 + wc * 32 + 4 * fq;
        const int c = (u.pm < 32) ? 0 : 1 + ((u.pm - 32) >> 2);
        const float* gate = modl + (size_t)c * 3072 + 2048 + col0;
        pg8::f32x4 gv[2][2];
#pragma unroll
        for (int bj = 0; bj < 2; ++bj)
#pragma unroll
            for (int n = 0; n < 2; ++n) gv[bj][n] = *(const pg8::f32x4*)(gate + bj * 128 + n * 16);
#pragma unroll
        for (int ai = 0; ai < 2; ++ai)
#pragma unroll
            for (int mp = 0; mp < 2; ++mp) {
                pg8::f32x4 xv[2][2][2];
#pragma unroll
                for (int mm = 0; mm < 2; ++mm) { const int row = row0 + ai * 128 + (mp * 2 + mm) * 16;
                    const float* xr = (layer == 0) ? ((row < NCTX) ? xp + (size_t)row * DM : xs + (size_t)(row - NCTX) * DM) : out + (size_t)row * DM;
#pragma unroll
                    for (int bj = 0; bj < 2; ++bj)
#pragma unroll
                        for (int n = 0; n < 2; ++n) xv[mm][bj][n] = *(const pg8::f32x4*)(xr + col0 + bj * 128 + n * 16); }
                asm volatile("" ::: "memory");
#pragma unroll
                for (int mm = 0; mm < 2; ++mm) { float* orow = out + (size_t)(row0 + ai * 128 + (mp * 2 + mm) * 16) * DM;
#pragma unroll
                    for (int bj = 0; bj < 2; ++bj)
#pragma unroll
                        for (int n = 0; n < 2; ++n) *(pg8::f32x4*)(orow + col0 + bj * 128 + n * 16) = xv[mm][bj][n] + gv[bj][n] * acc[ai][bj][mp * 2 + mm][n]; }
                asm volatile("" ::: "memory");
            }
    }
};

template <int FIXED_ACT> struct EpiProjT {
    static constexpr bool PERM = true, AFTER_DRAIN = false;
    bf16_t* O;
    __device__ __forceinline__ void operator()(const pg8::f32x4 (&acc)[2][2][4][2], const pg8::Unit& u, int wr, int wc, int fr, int fq) const {
        const int row0 = u.pm * 256 + wr * 64 + fr; const int col0 = u.pn * 256 + wc * 32 + 8 * fq;
        const int act = (FIXED_ACT >= 0) ? FIXED_ACT : (u.pn == 2 || u.pn == 3 || u.pn == 4 || u.pn == 5 || u.pn == 12 || u.pn == 13 || u.pn == 20 || u.pn == 21) ? 1 : (u.pn >= 6 && u.pn <= 9) ? 2 : 0;
#pragma unroll
        for (int ai = 0; ai < 2; ++ai)
#pragma unroll
            for (int m = 0; m < 4; ++m) { bf16_t* rowp = O + (size_t)(row0 + ai * 128 + m * 16) * DIN + col0;
#pragma unroll
                for (int bj = 0; bj < 2; ++bj) { pg8::f32x4 v0 = acc[ai][bj][m][0], v1 = acc[ai][bj][m][1];
                    if (act == 1) {
#pragma unroll
                        for (int j = 0; j < 4; ++j) { v0[j] = silu_f(v0[j]); v1[j] = silu_f(v1[j]); } }
                    else if (act == 2) {
#pragma unroll
                        for (int j = 0; j < 4; ++j) { v0[j] = __expf(-fmaxf(v0[j], -80.f)); v1[j] = __expf(-fmaxf(v1[j], -80.f)); } }
                    u32x4 w4; w4.x = pk2(v0[0], v0[1]); w4.y = pk2(v0[2], v0[3]); w4.z = pk2(v1[0], v1[1]); w4.w = pk2(v1[2], v1[3]);
                    *(u32x4*)(rowp + bj * 128) = w4; } }
    }
};

#define MFMA16(a, b, c) __builtin_amdgcn_mfma_f32_16x16x32_bf16((a), (b), (c), 0, 0, 0)
constexpr int G_QM = 0, G_QS = 17408, G_KM = 34816, G_KT = 52224, G_VT = 68608, G_ST = 84992, G_AT = 119808, G_GD = 129024, G_SEG = 129536;
constexpr int L_MISC = 140000;

__device__ __forceinline__ void unpack8v(const u32x4 p, float (&f)[8]) {
    f[0] = __uint_as_float(p.x << 16); f[1] = __uint_as_float(p.x & 0xffff0000u); f[2] = __uint_as_float(p.y << 16); f[3] = __uint_as_float(p.y & 0xffff0000u);
    f[4] = __uint_as_float(p.z << 16); f[5] = __uint_as_float(p.z & 0xffff0000u); f[6] = __uint_as_float(p.w << 16); f[7] = __uint_as_float(p.w & 0xffff0000u);
}
__device__ __forceinline__ u32x4 pack8v(const float (&f)[8]) { u32x4 o; o.x = pk2(f[0], f[1]); o.y = pk2(f[2], f[3]); o.z = pk2(f[4], f[5]); o.w = pk2(f[6], f[7]); return o; }

template <bool ISRET, bool ROPE> __device__ __forceinline__ void gla_item(const Ctx& X, const int l, const int isdec, const int seq, const int hgl, const int dir, LAS unsigned char* sm, const int tid, unsigned* ctr, unsigned& nxt) {
    const int lane = tid & 63, w = __builtin_amdgcn_readfirstlane(tid >> 6);
    const int c8 = lane & 15, g = lane >> 4, d0 = c8 * 8, i0 = (4 * w + g) * 2;
    const int L = isdec ? 1024 : 256, row0 = isdec ? NCTX + seq * 1024 : seq * 256, nch = L >> 6;
    constexpr bool isret = ISRET; const int h = hgl & 3;
    const unsigned qcol = (unsigned)((isret ? 3584 : 1024) + h * 128 + d0);
    const unsigned zcol = (unsigned)((isret ? 4096 : (dir ? 2048 : 1536)) + h * 128 + d0);
    const unsigned vcol = (unsigned)((isret ? 4608 : 2560) + h * 128 + d0);
    const int ocol = 512 + hgl * 128;
    bf16_t* OUT = dir ? X.OB : X.OF;
    float lbv[8]; float gam = 1.f;
#pragma unroll
    for (int c = 0; c < 8; ++c) lbv[c] = 0.f;
    if (!isret) { if (l == 1) {
#pragma unroll
            for (int c = 0; c < 8; ++c) { const float a0 = X.hgrn_lb_logits[(0 * 2 + dir) * 512 + h * 128 + d0 + c], a1 = X.hgrn_lb_logits[(1 * 2 + dir) * 512 + h * 128 + d0 + c]; lbv[c] = frcp(1.f + __expf(a0 - a1)); } } }
    else { gam = sigm_f(X.ret_decay_logit[(l * 2 + dir) * 4 + h]); }
    const float lg2 = log2f(gam), g32 = exp2f(32.0f * lg2);
    const int quad = lane >> 4, r16 = lane & 15;
    const int tr = w >> 1, cbk = w & 1, dtb = 2 * (w >> 1), etb = (w & 1) * 4;
    f32x4 S[2][4];
    if (isdec) {
        const float* st = (isret ? X.state_ret : X.state_hgrn) + (size_t)((((seq * 2 + l) * 2 + dir) * 4 + h) * 128) * 128;
#pragma unroll
        for (int a = 0; a < 2; ++a)
#pragma unroll
            for (int b = 0; b < 4; ++b)
#pragma unroll
                for (int j = 0; j < 4; ++j) S[a][b][j] = st[((dtb + a) * 16 + quad * 4 + j) * 128 + (etb + b) * 16 + r16];
    } else {
#pragma unroll
        for (int a = 0; a < 2; ++a)
#pragma unroll
            for (int b = 0; b < 4; ++b) S[a][b] = (f32x4){0.f, 0.f, 0.f, 0.f};
    }
#pragma unroll
    for (int a = 0; a < 2; ++a)
#pragma unroll
        for (int b = 0; b < 4; ++b) { u32x2 o; o.x = pk2(S[a][b][0], S[a][b][1]); o.y = pk2(S[a][b][2], S[a][b][3]);
            *(LAS u32x2*)(sm + G_ST + ((etb + b) * 16 + r16) * 272 + ((dtb + a) * 16 + quad * 4) * 2) = o; }
    u32x4 rq[2], rz[2], rv[2];
#define GLA_LOAD(ci) do { const int cb_ = dir ? (nch - 1 - (ci)) * 64 : (ci) * 64; \
        _Pragma("unroll") for (int tt = 0; tt < 2; ++tt) { const int t_ = dir ? cb_ + 63 - (i0 + tt) : cb_ + i0 + tt; const unsigned ro_ = (unsigned)(row0 + t_) * (unsigned)DIN; \
            rq[tt] = *(const u32x4*)(X.PROJ + ro_ + qcol); rz[tt] = *(const u32x4*)(X.PROJ + ro_ + zcol); rv[tt] = *(const u32x4*)(X.PROJ + ro_ + vcol); } } while (0)
    GLA_LOAD(0);
    for (int ci = 0; ci < nch; ++ci) {
        const int cb = dir ? (nch - 1 - ci) * 64 : ci * 64;
        if (ci == nch - 1 && tid == 0) nxt = atomicAdd(ctr, 1u);
        float qq[2][8], kk[2][8], cum[2][8];
        {
            float ff[2][8];
#pragma unroll
            for (int tt = 0; tt < 2; ++tt) {
                float qr[8], zr[8]; unpack8v(rq[tt], qr); unpack8v(rz[tt], zr);
                if (!isret) {
#pragma unroll
                    for (int c = 0; c < 8; ++c) { const float e = zr[c]; const float sg = frcp(1.f + e); const float oml = 1.f - lbv[c];
                        ff[tt][c] = fmaxf(lbv[c] + oml * sg, 1e-20f); kk[tt][c] = oml * (e * sg); qq[tt][c] = qr[c]; }
                } else {
                    if constexpr (ROPE) { const int t_ = dir ? cb + 63 - (i0 + tt) : cb + i0 + tt; const int pos = (c8 < 8) ? (t_ >> 6) : (t_ & 63);
                        const float* rp = X.ROPE + 2 * (pos * 32 + 8 * (c8 & 3));
                        const f32x4 cs0 = *(const f32x4*)(rp), cs1 = *(const f32x4*)(rp + 4), cs2 = *(const f32x4*)(rp + 8), cs3 = *(const f32x4*)(rp + 12);
                        const float cc[8] = {cs0.x, cs0.z, cs1.x, cs1.z, cs2.x, cs2.z, cs3.x, cs3.z}, ss[8] = {cs0.y, cs0.w, cs1.y, cs1.w, cs2.y, cs2.w, cs3.y, cs3.w};
                        const bool first = (c8 & 4) == 0;
#pragma unroll
                        for (int c = 0; c < 8; ++c) { const float qo = __shfl_xor(qr[c], 4), ko = __shfl_xor(zr[c], 4);
                            qr[c] = first ? qr[c] * cc[c] - qo * ss[c] : qo * ss[c] + qr[c] * cc[c];
                            zr[c] = first ? zr[c] * cc[c] - ko * ss[c] : ko * ss[c] + zr[c] * cc[c]; } }
                    const float pt = exp2f((float)(i0 + tt - 31) * lg2);
#pragma unroll
                    for (int c = 0; c < 8; ++c) { cum[tt][c] = pt; kk[tt][c] = zr[c]; qq[tt][c] = qr[c] * 0.08838834764831845f; }
                }
            }
            if (!isret) {
            float wt[8];
#pragma unroll
            for (int c = 0; c < 8; ++c) { const float tot = ff[0][c] * ff[1][c]; float inc = tot;
                float u = __shfl_up(inc, 16); if (g >= 1) inc *= u;
                u = __shfl_up(inc, 32); if (g >= 2) inc *= u;
                float exc = __shfl_up(inc, 16); if (g == 0) exc = 1.f;
                cum[0][c] = exc * ff[0][c]; cum[1][c] = inc; wt[c] = inc; }
            if (g == 3) { *(LAS f32x4*)(sm + G_SEG + (w * 128 + d0) * 4) = (f32x4){wt[0], wt[1], wt[2], wt[3]}; *(LAS f32x4*)(sm + G_SEG + (w * 128 + d0 + 4) * 4) = (f32x4){wt[4], wt[5], wt[6], wt[7]}; }
            }
        }
        __syncthreads();
        {
            float Eref[8], E47[8], Mq[8];
            if (isret) {
#pragma unroll
                for (int c = 0; c < 8; ++c) { Eref[c] = g32; E47[c] = g32; Mq[c] = 1.f; }
            } else {
#pragma unroll
                for (int c = 0; c < 8; ++c) { Eref[c] = 1.f; E47[c] = 1.f; Mq[c] = 1.f; }
#pragma unroll
                for (int k = 3; k >= 0; --k) { const f32x4 a = *(LAS f32x4*)(sm + G_SEG + (k * 128 + d0) * 4), b = *(LAS f32x4*)(sm + G_SEG + (k * 128 + d0 + 4) * 4);
                    Eref[0] *= a.x; Eref[1] *= a.y; Eref[2] *= a.z; Eref[3] *= a.w; Eref[4] *= b.x; Eref[5] *= b.y; Eref[6] *= b.z; Eref[7] *= b.w;
                    if (w == k) {
#pragma unroll
                        for (int c = 0; c < 8; ++c) Mq[c] = Eref[c]; } }
#pragma unroll
                for (int k = 4; k < 8; ++k) { const f32x4 a = *(LAS f32x4*)(sm + G_SEG + (k * 128 + d0) * 4), b = *(LAS f32x4*)(sm + G_SEG + (k * 128 + d0 + 4) * 4);
                    if (w == k) {
#pragma unroll
                        for (int c = 0; c < 8; ++c) Mq[c] = E47[c]; }
                    E47[0] *= a.x; E47[1] *= a.y; E47[2] *= a.z; E47[3] *= a.w; E47[4] *= b.x; E47[5] *= b.y; E47[6] *= b.z; E47[7] *= b.w; }
                if (w < 4) {
#pragma unroll
                    for (int c = 0; c < 8; ++c) Mq[c] = frcp(Mq[c]); }
            }
            if (w == 0 && g == 0) { *(LAS f32x4*)(sm + G_GD + d0 * 4) = (f32x4){Eref[0] * E47[0], Eref[1] * E47[1], Eref[2] * E47[2], Eref[3] * E47[3]};
                *(LAS f32x4*)(sm + G_GD + (d0 + 4) * 4) = (f32x4){Eref[4] * E47[4], Eref[5] * E47[5], Eref[6] * E47[6], Eref[7] * E47[7]}; }
            unsigned ktp[8], vtp[8]; float ks0[8];
#pragma unroll
            for (int tt = 0; tt < 2; ++tt) {
                float qm[8], qs[8], km[8];
#pragma unroll
                for (int c = 0; c < 8; ++c) { const float P = cum[tt][c] * Mq[c]; qm[c] = qq[tt][c] * P; qs[c] = qm[c] * Eref[c]; km[c] = kk[tt][c] * frcp(P);
                    const float ksv = km[c] * E47[c];
                    if (tt == 0) ks0[c] = ksv; else ktp[c] = pk2(ks0[c], ksv); }
                *(LAS u32x4*)(sm + G_QM + (i0 + tt) * 272 + d0 * 2) = pack8v(qm);
                *(LAS u32x4*)(sm + G_QS + (i0 + tt) * 272 + d0 * 2) = pack8v(qs);
                *(LAS u32x4*)(sm + G_KM + (i0 + tt) * 272 + d0 * 2) = pack8v(km);
            }
            {
                const unsigned a0 = rv[0].x, a1 = rv[0].y, a2 = rv[0].z, a3 = rv[0].w, b0 = rv[1].x, b1 = rv[1].y, b2 = rv[1].z, b3 = rv[1].w;
                vtp[0] = (a0 & 0xffffu) | (b0 << 16); vtp[1] = (a0 >> 16) | (b0 & 0xffff0000u); vtp[2] = (a1 & 0xffffu) | (b1 << 16); vtp[3] = (a1 >> 16) | (b1 & 0xffff0000u);
                vtp[4] = (a2 & 0xffffu) | (b2 << 16); vtp[5] = (a2 >> 16) | (b2 & 0xffff0000u); vtp[6] = (a3 & 0xffffu) | (b3 << 16); vtp[7] = (a3 >> 16) | (b3 & 0xffff0000u);
            }
            const int swz = ((w ^ (c8 & 7)) * 16) + 4 * g;
#pragma unroll
            for (int c = 0; c < 8; ++c) { *(LAS unsigned*)(sm + G_KT + (d0 + c) * 128 + swz) = ktp[c]; *(LAS unsigned*)(sm + G_VT + (d0 + c) * 128 + swz) = vtp[c]; }
        }
        if (ci + 1 < nch) GLA_LOAD(ci + 1);
        __syncthreads();
        f32x4 O[4];
        {
            bf16x8 aq[4];
#pragma unroll
            for (int ks = 0; ks < 4; ++ks) aq[ks] = *(LAS bf16x8*)(sm + G_QM + (tr * 16 + r16) * 272 + (ks * 32 + quad * 8) * 2);
#pragma unroll
            for (int tt = 0; tt < 2; ++tt) { const int tc = cbk * 2 + tt; f32x4 acc = (f32x4){0.f, 0.f, 0.f, 0.f};
                if (tc <= tr) {
#pragma unroll
                    for (int ks = 0; ks < 4; ++ks) { const bf16x8 bfr = *(LAS bf16x8*)(sm + G_KM + (tc * 16 + r16) * 272 + (ks * 32 + quad * 8) * 2); acc = MFMA16(aq[ks], bfr, acc); } }
#pragma unroll
                for (int j = 0; j < 4; ++j) { const int row = tr * 16 + quad * 4 + j, col = tc * 16 + r16; const float v = (col <= row) ? acc[j] : 0.f;
                    *(LAS bf16_t*)(sm + G_AT + row * 144 + col * 2) = (bf16_t)f2bf(v); } }
#pragma unroll
            for (int ks = 0; ks < 4; ++ks) aq[ks] = *(LAS bf16x8*)(sm + G_QS + (tr * 16 + r16) * 272 + (ks * 32 + quad * 8) * 2);
#pragma unroll
            for (int b = 0; b < 4; ++b) { O[b] = (f32x4){0.f, 0.f, 0.f, 0.f};
#pragma unroll
                for (int ks = 0; ks < 4; ++ks) { const bf16x8 afr = *(LAS bf16x8*)(sm + G_ST + ((etb + b) * 16 + r16) * 272 + (ks * 32 + quad * 8) * 2); O[b] = MFMA16(afr, aq[ks], O[b]); } }
        }
        __syncthreads();
        {
            const int nks = (tr >= 2) ? 2 : 1;
            for (int ks = 0; ks < nks; ++ks) { const bf16x8 bt = *(LAS bf16x8*)(sm + G_AT + (tr * 16 + r16) * 144 + (ks * 32 + quad * 8) * 2);
#pragma unroll
                for (int b = 0; b < 4; ++b) { const int R = (etb + b) * 16 + r16; const bf16x8 afr = *(LAS bf16x8*)(sm + G_VT + R * 128 + ((((ks * 4 + quad) ^ (R >> 3)) & 7) * 16)); O[b] = MFMA16(afr, bt, O[b]); } }
            {
                const int i_ = tr * 16 + r16; const int t_ = dir ? cb + 63 - i_ : cb + i_;
                bf16_t* op = OUT + (size_t)(row0 + t_) * DMIX + ocol + etb * 16 + quad * 4;
#pragma unroll
                for (int b = 0; b < 4; ++b) { u32x2 o; o.x = pk2(O[b][0], O[b][1]); o.y = pk2(O[b][2], O[b][3]); *(u32x2*)(op + b * 16) = o; }
            }
#pragma unroll
            for (int a = 0; a < 2; ++a) { const f32x4 g4 = *(LAS f32x4*)(sm + G_GD + ((dtb + a) * 16 + quad * 4) * 4);
#pragma unroll
                for (int b = 0; b < 4; ++b) S[a][b] = S[a][b] * g4; }
#pragma unroll
            for (int ks = 0; ks < 2; ++ks) {
                bf16x8 bfr[4];
#pragma unroll
                for (int b = 0; b < 4; ++b) { const int R = (etb + b) * 16 + r16; bfr[b] = *(LAS bf16x8*)(sm + G_VT + R * 128 + ((((ks * 4 + quad) ^ (R >> 3)) & 7) * 16)); }
#pragma unroll
                for (int a = 0; a < 2; ++a) { const int R = (dtb + a) * 16 + r16; const bf16x8 af = *(LAS bf16x8*)(sm + G_KT + R * 128 + ((((ks * 4 + quad) ^ (R >> 3)) & 7) * 16));
#pragma unroll
                    for (int b = 0; b < 4; ++b) S[a][b] = MFMA16(af, bfr[b], S[a][b]); } }
#pragma unroll
            for (int a = 0; a < 2; ++a)
#pragma unroll
                for (int b = 0; b < 4; ++b) { u32x2 o; o.x = pk2(S[a][b][0], S[a][b][1]); o.y = pk2(S[a][b][2], S[a][b][3]);
                    *(LAS u32x2*)(sm + G_ST + ((etb + b) * 16 + r16) * 272 + ((dtb + a) * 16 + quad * 4) * 2) = o; }
        }
    }
#undef GLA_LOAD
    if (!isdec) {
        float* fo = X.out + (isret ? 21037056 : 12648448) + (size_t)((((seq * 2 + l) * 2 + dir) * 4 + h) * 128) * 128;
#pragma unroll
        for (int a = 0; a < 2; ++a)
#pragma unroll
            for (int b = 0; b < 4; ++b)
#pragma unroll
                for (int j = 0; j < 4; ++j) fo[((dtb + a) * 16 + quad * 4 + j) * 128 + (etb + b) * 16 + r16] = S[a][b][j];
    }
}

constexpr int R_U = 0, R_WT = 18432, R_GT = 36864, R_SA = 104448, R_SB = 108544, R_HC = 112640;
__device__ __forceinline__ void lru_item(const Ctx& X, const int l, const int isdec, const int seq, const int hb, const int dir, LAS unsigned char* sm, const int tid, unsigned* ctr, unsigned& nxt) {
    const int lane = tid & 63, w = __builtin_amdgcn_readfirstlane(tid >> 6);
    const int ch = lane, tq = w;
    const int L = isdec ? 1024 : 256, row0 = isdec ? NCTX + seq * 1024 : seq * 256, nch = L >> 7;
    const int gch = hb * 64 + ch;
    bf16_t* OUT = dir ? X.OB : X.OF;
    {
        const float* wa = X.lru_wa + (size_t)(((l * 2 + dir) * 8 + hb) * 64) * 64; const float* wx = X.lru_wx + (size_t)(((l * 2 + dir) * 8 + hb) * 64) * 64;
        float wv[16];
#pragma unroll
        for (int q = 0; q < 16; ++q) { const int idx = tid + 512 * q; const int which = idx >> 12, k = (idx >> 6) & 63, n = idx & 63; wv[q] = (which ? wx : wa)[k * 64 + n]; }
#pragma unroll
        for (int q = 0; q < 16; ++q) { const int idx = tid + 512 * q; const int which = idx >> 12, k = (idx >> 6) & 63, n = idx & 63;
            *(LAS bf16_t*)(sm + R_WT + (which * 64 + n) * 144 + k * 2) = (bf16_t)f2bf(wv[q]); }
    }
    const float w0 = X.conv_w[(l * 4 + 0) * 512 + gch], w1 = X.conv_w[(l * 4 + 1) * 512 + gch], w2 = X.conv_w[(l * 4 + 2) * 512 + gch], w3 = X.conv_w[(l * 4 + 3) * 512 + gch];
    const float cbias = X.conv_b[l * 512 + gch];
    const float wq0 = dir ? w3 : 0.f, wq1 = dir ? w2 : w0, wq2 = w1, wq3 = dir ? w0 : w2, wq4 = dir ? 0.f : w3;
    const float ba = X.lru_ba[(l * 2 + dir) * 512 + gch], bx = X.lru_bx[(l * 2 + dir) * 512 + gch];
    const float lam = X.lru_lambda[(l * 2 + dir) * 512 + gch];
    const float sp = (lam > 15.f) ? __expf(-lam) : log1pf(__expf(-lam));
    if (tq == 0) *(LAS float*)(sm + R_HC + ch * 4) = isdec ? X.state_lru[((seq * 2 + l) * 2 + dir) * 512 + gch] : 0.f;
    const int quad = lane >> 4, r16 = lane & 15;
    const int sgn = dir ? -1 : 1;
    bf16_t ext[20];
#define LRU_LOAD(ci) do { const int cb_ = dir ? (nch - 1 - (ci)) * 128 : (ci) * 128; const int tb_ = dir ? cb_ + 127 - tq * 16 : cb_ + tq * 16; \
        _Pragma("unroll") for (int q = 0; q < 20; ++q) { const int t_ = tb_ + sgn * (q - 2); ext[q] = (t_ >= 0 && t_ < L) ? X.PROJ[(size_t)(row0 + t_) * DIN + gch] : (bf16_t)0; } } while (0)
    LRU_LOAD(0);
    __syncthreads();
    float hfin = 0.f;
    for (int ci = 0; ci < nch; ++ci) {
        if (ci == nch - 1 && tid == 0) nxt = atomicAdd(ctr, 1u);
        const int cb = dir ? (nch - 1 - ci) * 128 : ci * 128; const int tb = dir ? cb + 127 - tq * 16 : cb + tq * 16;
        const int par = ci & 1;
        float uu[16];
        { float xe[20];
#pragma unroll
          for (int q = 0; q < 20; ++q) xe[q] = bf2f(ext[q]);
          if (ci + 1 < nch) LRU_LOAD(ci + 1);
#pragma unroll
          for (int j = 0; j < 16; ++j) { uu[j] = cbias + wq0 * xe[j] + wq1 * xe[j + 1] + wq2 * xe[j + 2] + wq3 * xe[j + 3] + wq4 * xe[j + 4];
              *(LAS bf16_t*)(sm + R_U + (tq * 16 + j) * 144 + ch * 2) = (bf16_t)f2bf(uu[j]); } }
        {
            f32x4 acc[8];
#pragma unroll
            for (int b = 0; b < 8; ++b) acc[b] = (f32x4){0.f, 0.f, 0.f, 0.f};
#pragma unroll
            for (int ks = 0; ks < 2; ++ks) { const bf16x8 af = *(LAS bf16x8*)(sm + R_U + (tq * 16 + r16) * 144 + (ks * 32 + quad * 8) * 2);
#pragma unroll
                for (int b = 0; b < 8; ++b) { const bf16x8 bfr = *(LAS bf16x8*)(sm + R_WT + (b * 16 + r16) * 144 + (ks * 32 + quad * 8) * 2); acc[b] = MFMA16(af, bfr, acc[b]); } }
#pragma unroll
            for (int b = 0; b < 8; ++b)
#pragma unroll
                for (int j = 0; j < 4; ++j) *(LAS float*)(sm + R_GT + ((tq * 16 + quad * 4 + j) * 132 + b * 16 + r16) * 4) = acc[b][j];
        }
        float aa[16], bb[16]; float Al = 1.f, Bl = 0.f;
#pragma unroll
        for (int j = 0; j < 16; ++j) { const int i_ = tq * 16 + j;
            const float prr = *(LAS float*)(sm + R_GT + (i_ * 132 + ch) * 4) + ba, pri = *(LAS float*)(sm + R_GT + (i_ * 132 + 64 + ch) * 4) + bx;
            const float rg = sigm_f(prr), ig = sigm_f(pri);
            const float la = -8.0f * rg * sp; const float a = __expf(la);
            const float om = fmaf(-a, a, 1.0f);
            const float b = __builtin_amdgcn_sqrtf(om) * (ig * uu[j]);
            aa[j] = a; bb[j] = b; Al *= a; Bl = a * Bl + b; }
        *(LAS float*)(sm + R_SA + ((par * 8 + tq) * 64 + ch) * 4) = Al; *(LAS float*)(sm + R_SB + ((par * 8 + tq) * 64 + ch) * 4) = Bl;
        __syncthreads();
        float hh = *(LAS float*)(sm + R_HC + (par * 64 + ch) * 4);
        { float sa[7], sb[7];
#pragma unroll
          for (int s = 0; s < 7; ++s) { sa[s] = *(LAS float*)(sm + R_SA + ((par * 8 + s) * 64 + ch) * 4); sb[s] = *(LAS float*)(sm + R_SB + ((par * 8 + s) * 64 + ch) * 4); }
#pragma unroll
          for (int s = 0; s < 7; ++s) if (s < tq) hh = sa[s] * hh + sb[s]; }
#pragma unroll
        for (int j = 0; j < 16; ++j) { hh = aa[j] * hh + bb[j]; const int t_ = tb + sgn * j; OUT[(size_t)(row0 + t_) * DMIX + gch] = (bf16_t)f2bf(hh); }
        hfin = hh;
        if (tq == 7) *(LAS float*)(sm + R_HC + ((par ^ 1) * 64 + ch) * 4) = hh;
    }
#undef LRU_LOAD
    if (!isdec && tq == 7) X.out[12582912 + ((seq * 2 + l) * 2 + dir) * 512 + gch] = hfin;
}


struct InProjOrder : pg8::StaticOrder {
    __device__ bool next(int i, pg8::Unit& u) const {
        const long Lq = (long)i * G + c;
        if (Lq < 1008) return pg8::StaticOrder::next(i, u);
        if (Lq < 1024) { u.pm = 32 + (int)(Lq - 1008); u.pn = 21; return true; }
        return false;
    }
};
struct OneUnit {
    int pm, pn;
    __device__ bool next(int i, pg8::Unit& u) const { if (i > 0) return false; u.pm = pm; u.pn = pn; return true; }
    __device__ __forceinline__ void a_ready(const pg8::Unit&) const {}
    __device__ __forceinline__ void done(const pg8::Unit&) const {}
};
__device__ __forceinline__ void phase_mixer(const Ctx& X, const int l, LAS unsigned char* sm, const int tid, const int kin) {
    unsigned* ctr = X.ctl + 64 * l;
    __syncthreads();
    if (tid == 0) *(LAS unsigned*)(sm + L_MISC) = atomicAdd(ctr, 1u);
    __syncthreads();
    int it = (int)__builtin_amdgcn_readfirstlane(*(LAS unsigned*)(sm + L_MISC));
    while (it < 1184) {
        unsigned nxt = 0u;
        __syncthreads();
        if (it < 32) {
            if (tid == 0) nxt = atomicAdd(ctr, 1u);
            pg8::Gemm g{X.XN, X.WIN + (size_t)l * DIN * DM, NTOK, DIN, kin}; OneUnit S{it, 21};
            pg8::EpiBf16<0> E{X.PROJ, DIN, nullptr, 0, 0};
            pg8::gemm_phase<pg8::EpiBf16<0>, OneUnit, false>(sm, g, S, E, nullptr, launder_v(tid));
        } else {
            const int it2 = it - 32;
            const int isdec = (it2 < 128) ? 1 : 0; const int k = isdec ? it2 : it2 - 128; const int per = isdec ? 64 : 512;
            const int kind = (k >= per) ? 1 : 0; const int kk = kind ? k - per : k;
            const int tid2 = launder_v(tid);
            if (kind == 0) { const int hgl_ = (kk >> 1) & 7;
                if (hgl_ < 4) gla_item<false, false>(X, l, isdec, kk >> 4, hgl_, kk & 1, sm, tid2, ctr, nxt);
                else if (isdec) gla_item<true, true>(X, l, 1, kk >> 4, hgl_, kk & 1, sm, tid2, ctr, nxt);
                else gla_item<true, false>(X, l, 0, kk >> 4, hgl_, kk & 1, sm, tid2, ctr, nxt); }
            else lru_item(X, l, isdec, kk >> 4, (kk >> 1) & 7, kk & 1, sm, tid2, ctr, nxt);
        }
        if (tid == 0) *(LAS unsigned*)(sm + L_MISC) = nxt;
        __syncthreads();
        it = (int)__builtin_amdgcn_readfirstlane(*(LAS unsigned*)(sm + L_MISC));
    }
}

#define XB_TMO      128
#define XB_XCNT(j)  (256  + 64 * (j))
#define XB_XSUB(j)  (1280 + 64 * (j))
#define XB_XGEN(j)  (2304 + 64 * (j))
#define XB_TOP      3328
#define XB_TOPGEN   3392
#define XCD_BAR_WORDS 3456
#define XB_SPIN_CAP (1u << 18)

__device__ __forceinline__ unsigned xb_ld(unsigned* p)              { return __hip_atomic_load(p, __ATOMIC_RELAXED, __HIP_MEMORY_SCOPE_AGENT); }
__device__ __forceinline__ unsigned xb_add(unsigned* p, unsigned v) { return __hip_atomic_fetch_add(p, v, __ATOMIC_RELAXED, __HIP_MEMORY_SCOPE_AGENT); }
__device__ __forceinline__ unsigned xb_xcc_id() { return (unsigned)__builtin_amdgcn_s_getreg((3 << 11) | 20) & 0xFu; }
#define XB_SPIN(cond, bar) do { unsigned _sp = 0; while (cond) { __builtin_amdgcn_s_sleep(1); \
    if ((++_sp & 255u) == 0u) { if (xb_ld(&(bar)[XB_TMO])) break; if (_sp > XB_SPIN_CAP) { atomicAdd(&(bar)[XB_TMO], 1u); break; } } } } while (0)

struct XcdBarrier {
    unsigned* bar; unsigned x;
    volatile LAS unsigned* st;
};

__device__ __forceinline__ XcdBarrier xcd_barrier_post(unsigned* bar, volatile LAS unsigned* st) {
    XcdBarrier b; b.bar = bar; b.x = xb_xcc_id(); b.st = st;
    if (threadIdx.x == 0) (void)xb_add(&bar[XB_XCNT(b.x)], 1u);
    return b;
}
__device__ __forceinline__ void xcd_barrier_complete(unsigned* bar, unsigned x, unsigned& nloc, unsigned& nx) {
    const unsigned G = gridDim.x * gridDim.y * gridDim.z;
    unsigned sum, cnt, mine, sp = 0u;
    for (;;) {
        sum = 0u; cnt = 0u; mine = 0u;
#pragma unroll
        for (unsigned j = 0; j < 16; ++j) { const unsigned c = xb_ld(&bar[XB_XCNT(j)]); sum += c; cnt += (c > 0u) ? 1u : 0u; mine = (j == x) ? c : mine; }
        if (sum == G) break;
        __builtin_amdgcn_s_sleep(1);
        if ((++sp & 255u) == 0u) { if (xb_ld(&bar[XB_TMO])) break; if (sp > XB_SPIN_CAP) { atomicAdd(&bar[XB_TMO], 1u); break; } }
    }
    nloc = mine > 0u ? mine : 1u; nx = cnt > 0u ? cnt : 1u;
}

__device__ __forceinline__ void xcd_barrier(const XcdBarrier& b) {
    asm volatile("s_waitcnt vmcnt(0)" ::: "memory");
    __syncthreads();
    if (threadIdx.x == 0) {
        unsigned* bar = b.bar;
        __builtin_amdgcn_s_waitcnt(0);
        unsigned nloc = b.st[0], nx = b.st[1];
        if (nloc == 0u) { xcd_barrier_complete(bar, b.x, nloc, nx); b.st[0] = nloc; b.st[1] = nx; }
        const unsigned old = xb_add(&bar[XB_XSUB(b.x)], 1u);
        const unsigned gen = old / nloc;
        if (old + 1u == (gen + 1u) * nloc) {
            __builtin_amdgcn_fence(__ATOMIC_RELEASE, "agent");
            asm volatile("s_waitcnt vmcnt(0)" ::: "memory");
            const unsigned og = xb_add(&bar[XB_TOP], 1u);
            const unsigned tg = og / nx;
            if (og + 1u == (tg + 1u) * nx) xb_add(&bar[XB_TOPGEN], 1u);
            else XB_SPIN(xb_ld(&bar[XB_TOPGEN]) == tg, bar);
            __builtin_amdgcn_fence(__ATOMIC_ACQUIRE, "agent");
            xb_add(&bar[XB_XGEN(b.x)], 1u);
            asm volatile("s_waitcnt vmcnt(0)" ::: "memory");
        } else {
            XB_SPIN(xb_ld(&bar[XB_XGEN(b.x)]) == gen, bar);
            __builtin_amdgcn_fence(__ATOMIC_ACQUIRE, "agent");
            asm volatile("s_waitcnt vmcnt(0)" ::: "memory");
        }
    }
    __syncthreads();
}

template <class T> __device__ __forceinline__ T* as_global(T* q) {
#if defined(__HIP_DEVICE_COMPILE__)
    return (T*)(__attribute__((address_space(1))) T*)q;
#else
    return q;
#endif
}
__device__ __forceinline__ const void* kernarg_ptr() {
#if defined(__HIP_DEVICE_COMPILE__)
    return (const void*)__builtin_amdgcn_kernarg_segment_ptr();
#else
    return nullptr;
#endif
}
__device__ __forceinline__ int kernarg_int(int off) {
#if defined(__HIP_DEVICE_COMPILE__)
    return *(const __attribute__((address_space(4))) int*)((const __attribute__((address_space(4))) char*)__builtin_amdgcn_kernarg_segment_ptr() + off);
#else
    return 0;
#endif
}
__device__ __forceinline__ Ctx make_ctx() {
#if defined(__HIP_DEVICE_COMPILE__)
    const __attribute__((address_space(4))) ParamsG* kp_ = (const __attribute__((address_space(4))) ParamsG*)__builtin_amdgcn_kernarg_segment_ptr(); asm volatile("" : "+s"(kp_));
    const __attribute__((address_space(4))) ParamsG& p = *kp_;
#else
    const ParamsG pp_{}; const ParamsG& p = pp_;
#endif
    Ctx X;
    X.x_prompt = (const float*)p.in[0]; X.x_sample = (const float*)p.in[1]; X.state_lru = (const float*)p.in[2]; X.state_hgrn = (const float*)p.in[3]; X.state_ret = (const float*)p.in[4]; X.c = (const float*)p.in[5]; X.c_ctx = (const float*)p.in[6]; X.norm_g = (const float*)p.in[7];
    X.w_mod = (const float*)p.in[8]; X.b_mod = (const float*)p.in[9]; X.w_in = (const float*)p.in[10]; X.conv_w = (const float*)p.in[11]; X.conv_b = (const float*)p.in[12]; X.lru_wa = (const float*)p.in[13]; X.lru_ba = (const float*)p.in[14]; X.lru_wx = (const float*)p.in[15];
    X.lru_bx = (const float*)p.in[16]; X.lru_lambda = (const float*)p.in[17]; X.hgrn_lb_logits = (const float*)p.in[18]; X.hgrn_norm_g = (const float*)p.in[19]; X.ret_decay_logit = (const float*)p.in[20]; X.ret_norm_g = (const float*)p.in[21];
    X.w_out = (const float*)p.in[22]; X.final_g = (const float*)p.in[23]; X.out = (float*)p.out; unsigned char* ws_ = (unsigned char*)p.ws;
    X.ctl = (unsigned*)(ws_ + WS_CTL); X.MOD = (float*)(ws_ + WS_MOD); X.ROPE = (float*)(ws_ + WS_ROPE);
    X.WIN = (bf16_t*)(ws_ + WS_WIN); X.WOUT = (bf16_t*)(ws_ + WS_WOUT); X.PROJ = (bf16_t*)(ws_ + WS_PROJ); X.OF = (bf16_t*)(ws_ + WS_OF); X.OB = (bf16_t*)(ws_ + WS_OB); X.XN = (bf16_t*)(ws_ + WS_XN);

    return X;
}

constexpr int CW_BAR = 1024;
constexpr int L_BARST = 140016;
__device__ __forceinline__ void mk_barrier(LAS unsigned char* sm) {
    const Ctx X = make_ctx();
    XcdBarrier b; b.bar = X.ctl + CW_BAR; b.x = xb_xcc_id(); b.st = (volatile LAS unsigned*)(sm + L_BARST);
    xcd_barrier(b);
}

constexpr int CW_XLOC = 4608;
constexpr int CW_XLB = 5632;
constexpr int CW_POSTDONE = 6720;
constexpr int L_XID = L_BARST + 16;
__device__ __forceinline__ void xl_barrier(unsigned* ctl, LAS unsigned char* sm, const int tid, const unsigned* extra = nullptr, const unsigned extra_target = 0u) {
    asm volatile("s_waitcnt vmcnt(0)" ::: "memory");
    __syncthreads();
    if (tid == 0) {
        unsigned* c = ctl + CW_XLB + 64 * *(LAS unsigned*)(sm + L_XID);
        const unsigned old = __hip_atomic_fetch_add(c, 1u, __ATOMIC_RELAXED, __HIP_MEMORY_SCOPE_AGENT);
        const unsigned target = (old / 32u + 1u) * 32u; unsigned sp = 0;
        for (;;) {
            const unsigned e = extra ? __hip_atomic_load(extra, __ATOMIC_RELAXED, __HIP_MEMORY_SCOPE_AGENT) : extra_target;
            const unsigned v = __hip_atomic_load(c, __ATOMIC_RELAXED, __HIP_MEMORY_SCOPE_AGENT);
            if ((v >= target && e >= extra_target) || ++sp > (1u << 22)) break;
            __builtin_amdgcn_s_sleep(1); }
        __builtin_amdgcn_fence(__ATOMIC_ACQUIRE, "agent"); asm volatile("s_waitcnt vmcnt(0)" ::: "memory");
    }
    __syncthreads();
}
struct OutOrder {
    pg8::StaticOrder so; int fast, pm, pn, has;
    __device__ bool next(int i, pg8::Unit& u) const { if (!fast) return so.next(i, u); if (i > 0 || !has) return false; u.pm = pm; u.pn = pn; return true; }
    __device__ __forceinline__ void a_ready(const pg8::Unit&) const {}
    __device__ __forceinline__ void done(const pg8::Unit&) const {}
};
template <int l> __device__ __forceinline__ void layer_phases(cg::grid_group& grid, LAS unsigned char* sm, const int wave_s) {
#define XCC_ID ((int)__builtin_amdgcn_readfirstlane(*(LAS unsigned*)(sm + L_XID)))
#define XCC_LI ((int)__builtin_amdgcn_readfirstlane(*(LAS unsigned*)(sm + L_XID + 4)))
#define XFAST (__builtin_amdgcn_readfirstlane(*(LAS unsigned*)(sm + L_XID + 8)) != 0u)
#define XBASE (XFAST ? XCC_ID * 1536 + XCC_LI * 48 : -1)
        if constexpr (l != 0) {
            if (!XFAST) {
                { const Ctx X = make_ctx(); phase_xn(X, l, tid_of(wave_s)); }
                mk_barrier(sm);
            }
        }
        {
            const Ctx X = make_ctx(); const int kin = kernarg_int(208);
            pg8::Gemm g{X.XN, X.WIN + (size_t)l * DIN * DM, NTOK, DIN, kin}; InProjOrder S; S.init(NTOK, DIN - 256, (int)gridDim.x, (int)blockIdx.x);
            EpiProjT<-1> E{X.PROJ};
            pg8::gemm_phase<EpiProjT<-1>, InProjOrder, false>(sm, g, S, E, nullptr, tid_of(wave_s));
        }
        mk_barrier(sm);
        { const Ctx X = make_ctx(); phase_mixer(X, l, sm, tid_of(wave_s), kernarg_int(208)); }
        mk_barrier(sm);
        { const Ctx X = make_ctx(); phase_post(X, l, tid_of(wave_s), XBASE); }
        if (XFAST) { const Ctx X = make_ctx(); xl_barrier(X.ctl, sm, tid_of(wave_s));
            if constexpr (l == 0) { if (tid_of(wave_s) == 0) __hip_atomic_fetch_add(X.ctl + CW_POSTDONE, 1u, __ATOMIC_RELAXED, __HIP_MEMORY_SCOPE_AGENT); }
        } else mk_barrier(sm);
        {
            const Ctx X = make_ctx(); const int kout = kernarg_int(212);
            pg8::Gemm g{X.OF, X.WOUT + (size_t)l * DM * DMIX, NTOK, DM, kout};
            OutOrder S; S.so.init(NTOK, DM, (int)gridDim.x, (int)blockIdx.x); { const int xli = XCC_LI; S.fast = XFAST ? 1 : 0; S.has = (S.fast && xli < 24) ? 1 : 0; S.pm = XCC_ID * 6 + (xli >> 2); S.pn = xli & 3; }
            EpiResid E{X.x_prompt, X.x_sample, X.out, X.MOD + (size_t)l * 5 * 3072, l};
            pg8::gemm_phase<EpiResid, OutOrder, false>(sm, g, S, E, nullptr, tid_of(wave_s));
            if constexpr (l == 0) {
                if (XFAST) { const int xli = XCC_LI; l1_weights_idle(X, sm, tid_of(wave_s), (xli >= 24) ? XCC_ID * 8 + (xli - 24) : -1, 64); }
                else if (gridDim.x > 192) l1_weights_idle(X, sm, tid_of(wave_s), (int)blockIdx.x - 192, (int)gridDim.x - 192);
                else l1_weights_idle(X, sm, tid_of(wave_s), (int)blockIdx.x, (int)gridDim.x);
            }
        }
        if (XFAST) {
            { const Ctx X = make_ctx(); if constexpr (l == 0) xl_barrier(X.ctl, sm, tid_of(wave_s), X.ctl + CW_POSTDONE, gridDim.x); else xl_barrier(X.ctl, sm, tid_of(wave_s)); }
            if constexpr (l == 0) {
                { const Ctx X = make_ctx(); phase_xn(X, 1, tid_of(wave_s), XBASE); } mk_barrier(sm); }
            else { const Ctx X = make_ctx(); phase_final(X, tid_of(wave_s), XBASE); }
        } else mk_barrier(sm);
    }
#undef XCC_ID
#undef XCC_LI
#undef XFAST
#undef XBASE
__global__ void __launch_bounds__(512, 2) fwd_megakernel(Params p) {
    extern __shared__ __attribute__((aligned(16))) unsigned char lds[];
    cg::grid_group grid = cg::this_grid();
    LAS unsigned char* sm = (LAS unsigned char*)lds;
    const int wave_s = __builtin_amdgcn_readfirstlane(threadIdx.x >> 6);
    if (threadIdx.x < 2) *(LAS unsigned*)(sm + L_BARST + 4 * threadIdx.x) = 0u;
    if (threadIdx.x == 0) { const Ctx X = make_ctx(); const unsigned x = xb_xcc_id();
        *(LAS unsigned*)(sm + L_XID) = x; *(LAS unsigned*)(sm + L_XID + 4) = __hip_atomic_fetch_add(X.ctl + CW_XLOC + 64 * x, 1u, __ATOMIC_RELAXED, __HIP_MEMORY_SCOPE_AGENT); *(LAS unsigned*)(sm + L_XID + 8) = 0u; }
    __syncthreads();
    { const Ctx X = make_ctx(); (void)xcd_barrier_post(X.ctl + CW_BAR, (volatile LAS unsigned*)(sm + L_BARST)); }
    { const Ctx X = make_ctx(); phase0(X, sm, tid_of(wave_s)); }
    { const Ctx X = make_ctx(); phase_xn(X, 0, tid_of(wave_s)); }
    mk_barrier(sm);
    if (threadIdx.x == 0) {
        const Ctx X = make_ctx(); unsigned ok = 1u, nx = 0u;
        for (int j = 0; j < 16; ++j) { const unsigned c = __hip_atomic_load(X.ctl + CW_XLOC + 64 * j, __ATOMIC_RELAXED, __HIP_MEMORY_SCOPE_AGENT); if (c) { ++nx; if (c != 32u || j >= 8) ok = 0u; } }
        if (nx != 8u || gridDim.x != 256u) ok = 0u;
        *(LAS unsigned*)(sm + L_XID + 8) = ok; }
    __syncthreads();
    layer_phases<0>(grid, sm, wave_s);
    layer_phases<1>(grid, sm, wave_s);
    if (*(LAS unsigned*)(sm + L_XID + 8) == 0u) { const Ctx X = make_ctx(); phase_final(X, tid_of(wave_s)); }
}

extern "C" void kernel_launch(void* const* d_in, const int* in_sizes, int n_in, void* d_out, int out_size, void* d_ws, size_t ws_size, hipStream_t stream) {
    static int grid_blocks = 0;
    if (grid_blocks == 0) {
        int dev = 0, cus = 0, per_cu = 0;
        hipGetDevice(&dev);
        hipDeviceGetAttribute(&cus, hipDeviceAttributeMultiprocessorCount, dev);
        if (hipFuncSetAttribute((const void*)fwd_megakernel, hipFuncAttributeMaxDynamicSharedMemorySize, LDS_BYTES) != hipSuccess) { fprintf(stderr, "hipFuncSetAttribute failed\n"); }
        if (hipOccupancyMaxActiveBlocksPerMultiprocessor(&per_cu, (const void*)fwd_megakernel, 512, LDS_BYTES) != hipSuccess || per_cu < 1) { fprintf(stderr, "occupancy query: %d\n", per_cu); per_cu = 1; }
        (void)hipGetLastError();
        grid_blocks = cus * 1;
        if (ws_size < WS_END) { fprintf(stderr, "workspace too small: %zu\n", ws_size); grid_blocks = -1; }
    }
    if (grid_blocks < 0) return;
    Params p{};
    for (int i = 0; i < 24; ++i) p.in[i] = (const float*)d_in[i];
    p.out = (float*)d_out; p.ws = (unsigned char*)d_ws; p.kin = DM; p.kout = DMIX;
    if (hipMemsetAsync((char*)d_ws + WS_CTL, 0, 64 * 1024, stream) != hipSuccess) { fprintf(stderr, "memset failed\n"); return; }
    void* args[] = {&p};
    hipError_t e = hipLaunchCooperativeKernel((const void*)fwd_megakernel, dim3(grid_blocks), dim3(512), args, LDS_BYTES, stream);
    if (e != hipSuccess) fprintf(stderr, "cooperative launch failed: %s (grid %d)\n", hipGetErrorString(e), grid_blocks);
}
```
